# Optimizing an MI355X kernel written in HIP

```python
import jax, jax.numpy as jnp
from jax import lax
import numpy as np

D_MODEL = 2048
BATCH = 4
SEQ = 2048
DEPTH = 2

GRID_W = 64
CTX_LEN = 256
EPS = 1e-6
NEG_INF = -1e30
ROPE_THETA = 10000.0
Q_BLOCK = 128

V_DIM = 128
MLA_WIDTH = D_MODEL // 2
MLA_HEADS = MLA_WIDTH // V_DIM
QK_NOPE = 128
QK_ROPE = 64
Q_LORA = D_MODEL // 4
KV_LORA = D_MODEL // 8
FNET_WIDTH = D_MODEL // 4
FNET_GROUP_DIM = 128
FNET_GROUPS = FNET_WIDTH // FNET_GROUP_DIM
NA_WIDTH = D_MODEL // 4
NA_HEAD_DIM = 128
NA_HEADS = NA_WIDTH // NA_HEAD_DIM
NA_KH_MAX = 8
NA_KW = 16
MIX_WIDTH = MLA_WIDTH + FNET_WIDTH + NA_WIDTH
IN_SIZES = (Q_LORA, KV_LORA, QK_ROPE, FNET_WIDTH, NA_WIDTH, NA_WIDTH, NA_WIDTH)
IN_COLS = Q_LORA + KV_LORA + QK_ROPE + FNET_WIDTH + 3 * NA_WIDTH
N_GROUPS = 4
EXPERTS_PER_GROUP = 8
N_EXPERTS = N_GROUPS * EXPERTS_PER_GROUP
TOP_K = 2
D_EXPERT = D_MODEL // 4

kernel_name = 'hybrid_mla_fnet_natten_hmoe_dit'


def rmsnorm(x, g):
    xf = x.astype(jnp.float32)
    y = xf * lax.rsqrt(jnp.mean(xf * xf, axis=-1, keepdims=True) + EPS)
    return (y * g.astype(jnp.float32)).astype(x.dtype)


def modulate(h, shift, scale):
    return h * (1.0 + scale) + shift


def modulation(cond, w_ada, b_ada):
    m = jnp.dot(jax.nn.silu(cond), w_ada) + b_ada
    return jnp.split(m, 6, axis=-1)


def split_columns(z, sizes):
    out, start = [], 0
    for s in sizes:
        out.append(z[..., start:start + s])
        start += s
    return out


def axial_rope(n_tokens):
    half = QK_ROPE // 2
    inv_freq = ROPE_THETA ** (-jnp.arange(0, half, 2, dtype=jnp.float32) / half)
    t = jnp.arange(n_tokens, dtype=jnp.int32)
    row = (t // GRID_W).astype(jnp.float32)
    col = (t % GRID_W).astype(jnp.float32)
    ang = jnp.concatenate([row[:, None] * inv_freq, col[:, None] * inv_freq], axis=-1)
    return jnp.cos(ang), jnp.sin(ang)


def apply_rope(x, cos, sin):
    xf = x.astype(jnp.float32)
    x1, x2 = xf[..., 0::2], xf[..., 1::2]
    out = jnp.stack([x1 * cos - x2 * sin, x1 * sin + x2 * cos], axis=-1).reshape(x.shape)
    return out.astype(x.dtype)


def attend(q, k, v, scale):
    s = jnp.einsum('bqhd,bkhd->bhqk', q, k).astype(jnp.float32) * scale
    p = jax.nn.softmax(s, axis=-1).astype(v.dtype)
    return jnp.einsum('bhqk,bkhd->bqhd', p, v)


def block_attention(q, k, v, scale):
    B, L, H, dk = q.shape
    nb = L // Q_BLOCK
    qb = jnp.moveaxis(q.reshape(B, nb, Q_BLOCK, H, dk), 1, 0)
    o = lax.map(lambda qq: attend(qq, k, v, scale), qb)
    return jnp.moveaxis(o, 0, 1).reshape(B, L, H, v.shape[-1])


def mla_queries(zq, g_q, w_uq, rope):
    B, L, _ = zq.shape
    q = (rmsnorm(zq, g_q) @ w_uq).reshape(B, L, MLA_HEADS, QK_NOPE + QK_ROPE)
    if rope is None:
        return q
    cos, sin = rope
    q_rope = apply_rope(q[..., QK_NOPE:], cos[:, None, :], sin[:, None, :])
    return jnp.concatenate([q[..., :QK_NOPE], q_rope], axis=-1)


def mla_keys_values(zkv, zkr, g_kv, w_ukv, rope):
    B, L, _ = zkv.shape
    kv = (rmsnorm(zkv, g_kv) @ w_ukv).reshape(B, L, MLA_HEADS, QK_NOPE + V_DIM)
    k_rope = zkr if rope is None else apply_rope(zkr, rope[0], rope[1])
    k_rope = jnp.broadcast_to(k_rope[:, :, None, :], (B, L, MLA_HEADS, QK_ROPE))
    k = jnp.concatenate([kv[..., :QK_NOPE], k_rope], axis=-1)
    return k, kv[..., QK_NOPE:]


def fourier_mix(z, w_fnet, b_fnet):
    B, L, _ = z.shape
    zg = z.astype(jnp.float32).reshape(B, L, FNET_GROUPS, FNET_GROUP_DIM)
    f = jnp.fft.fftn(zg, axes=(1, 3), norm='ortho').real
    return f.reshape(B, L, FNET_WIDTH).astype(z.dtype) @ w_fnet + b_fnet


def neighbourhood_attention(q, k, v, k_ctx, v_ctx, rpb):
    B, S, H, dh = q.shape
    rows = S // GRID_W
    kh = min(NA_KH_MAX, rows)
    r = np.arange(rows)
    row_start = np.clip(r - kh // 2, 0, rows - kh)
    row_idx = row_start[:, None] + np.arange(kh)[None, :]
    cq = np.arange(GRID_W)
    ck = np.arange(GRID_W)
    col_start = np.clip(cq - NA_KW // 2, 0, GRID_W - NA_KW)
    in_win = (ck[None, :] >= col_start[:, None]) & (ck[None, :] < col_start[:, None] + NA_KW)
    drow = row_idx - r[:, None] + (NA_KH_MAX - 1)
    dcol = np.clip(ck[None, :] - cq[:, None] + (NA_KW - 1), 0, 2 * NA_KW - 2)
    bias = rpb[:, drow[:, None, :, None], dcol[None, :, None, :]].astype(jnp.float32)
    bias = jnp.where(in_win[None, None, :, None, :], bias, NEG_INF).reshape(H, rows, GRID_W, kh * GRID_W)
    n_loc = kh * GRID_W
    qg = q.reshape(B, rows, GRID_W, H, dh)
    kb = k.reshape(B, rows, GRID_W, H, dh)[:, row_idx].reshape(B, rows, n_loc, H, dh)
    vb = v.reshape(B, rows, GRID_W, H, dh)[:, row_idx].reshape(B, rows, n_loc, H, dh)
    scale = NA_HEAD_DIM ** -0.5
    s_loc = jnp.einsum('brqhd,brkhd->bhrqk', qg, kb).astype(jnp.float32) * scale + bias[None]
    s_ctx = jnp.einsum('brqhd,bkhd->bhrqk', qg, k_ctx).astype(jnp.float32) * scale
    p = jax.nn.softmax(jnp.concatenate([s_loc, s_ctx], axis=-1), axis=-1).astype(v.dtype)
    o = (jnp.einsum('bhrqk,brkhd->brqhd', p[..., :n_loc], vb)
         + jnp.einsum('bhrqk,bkhd->brqhd', p[..., n_loc:], v_ctx))
    return o.reshape(B, S, H * dh)


def merge_groups(o_mla, o_f, o_na, g_out, w_out):
    g_mla = g_out[:MLA_WIDTH]
    g_f = g_out[MLA_WIDTH:MLA_WIDTH + FNET_WIDTH]
    g_na = g_out[MLA_WIDTH + FNET_WIDTH:]
    y = jnp.concatenate([rmsnorm(o_mla, g_mla), rmsnorm(o_f, g_f), rmsnorm(o_na, g_na)], axis=-1)
    return y @ w_out


def hier_moe(h, w_rg, b_rg, w_re, b_re, w_gate, w_up, w_down):
    B, L, D = h.shape
    t = h.reshape(B * L, D)
    g_prob = jax.nn.softmax((t @ w_rg + b_rg).astype(jnp.float32), axis=-1)
    g_sel = jnp.argmax(g_prob, axis=-1)
    g_w = jnp.take_along_axis(g_prob, g_sel[:, None], axis=1)
    e_logits = (t @ w_re + b_re).astype(jnp.float32).reshape(-1, N_GROUPS, EXPERTS_PER_GROUP)
    e_logits = jnp.take_along_axis(e_logits, g_sel[:, None, None], axis=1)[:, 0]
    e_prob = jax.nn.softmax(e_logits, axis=-1)
    top_p, top_i = lax.top_k(e_prob, TOP_K)
    top_p = top_p / jnp.sum(top_p, axis=-1, keepdims=True)
    e_gate = jnp.einsum('tk,tke->te', top_p, jax.nn.one_hot(top_i, EXPERTS_PER_GROUP, dtype=jnp.float32)) * g_w
    gate = (jax.nn.one_hot(g_sel, N_GROUPS, dtype=jnp.float32)[:, :, None] * e_gate[:, None, :]).astype(h.dtype)
    out = jnp.zeros_like(t)
    for g in range(N_GROUPS):
        a = jnp.einsum('td,edf->tef', t, w_gate[g])
        u = jnp.einsum('td,edf->tef', t, w_up[g])
        out = out + jnp.einsum('tef,efd->td', jax.nn.silu(a) * u * gate[:, g, :, None], w_down[g])
    return out.reshape(B, L, D)


def layer(x, xc, c, c_ctx, w_ada, b_ada, g_attn, g_ffn, w_in, g_q, w_uq, g_kv, w_ukv,
          w_fnet, b_fnet, na_rpb, g_out, w_out, w_rg, b_rg, w_re, b_re, w_gate, w_up, w_down,
          rope, ctx_out):
    B, S, _ = x.shape
    Lc = xc.shape[1]
    shift_a, scale_a, gate_a, shift_f, scale_f, gate_f = [m[:, None, :] for m in modulation(c, w_ada, b_ada)]
    shift_ac, scale_ac, gate_ac, shift_fc, scale_fc, gate_fc = modulation(c_ctx, w_ada, b_ada)

    h = modulate(rmsnorm(x, g_attn), shift_a, scale_a)
    hc = modulate(rmsnorm(xc, g_attn), shift_ac, scale_ac)
    zq, zkv, zkr, zf, zna_q, zna_k, zna_v = split_columns(h @ w_in, IN_SIZES)
    cq, ckv, ckr, cf, cna_q, cna_k, cna_v = split_columns(hc @ w_in, IN_SIZES)

    mla_scale = (QK_NOPE + QK_ROPE) ** -0.5
    na_scale = NA_HEAD_DIM ** -0.5
    k_lat, v_lat = mla_keys_values(zkv, zkr, g_kv, w_ukv, rope)
    k_ctx, v_ctx = mla_keys_values(ckv, ckr, g_kv, w_ukv, None)
    q_lat = mla_queries(zq, g_q, w_uq, rope)
    o_mla = block_attention(q_lat, jnp.concatenate([k_ctx, k_lat], axis=1),
                            jnp.concatenate([v_ctx, v_lat], axis=1), mla_scale).reshape(B, S, MLA_WIDTH)
    o_f = fourier_mix(zf, w_fnet, b_fnet)
    na_k_ctx = cna_k.reshape(B, Lc, NA_HEADS, NA_HEAD_DIM)
    na_v_ctx = cna_v.reshape(B, Lc, NA_HEADS, NA_HEAD_DIM)
    o_na = neighbourhood_attention(zna_q.reshape(B, S, NA_HEADS, NA_HEAD_DIM),
                                   zna_k.reshape(B, S, NA_HEADS, NA_HEAD_DIM),
                                   zna_v.reshape(B, S, NA_HEADS, NA_HEAD_DIM),
                                   na_k_ctx, na_v_ctx, na_rpb)
    x = x + gate_a * merge_groups(o_mla, o_f, o_na, g_out, w_out)
    hf = modulate(rmsnorm(x, g_ffn), shift_f, scale_f)

    if not ctx_out:
        return x + gate_f * hier_moe(hf, w_rg, b_rg, w_re, b_re, w_gate, w_up, w_down), xc

    oc_mla = attend(mla_queries(cq, g_q, w_uq, None), k_ctx, v_ctx, mla_scale).reshape(B, Lc, MLA_WIDTH)
    oc_f = fourier_mix(cf, w_fnet, b_fnet)
    oc_na = attend(cna_q.reshape(B, Lc, NA_HEADS, NA_HEAD_DIM), na_k_ctx, na_v_ctx, na_scale).reshape(B, Lc, NA_WIDTH)
    xc = xc + gate_ac * merge_groups(oc_mla, oc_f, oc_na, g_out, w_out)
    hfc = modulate(rmsnorm(xc, g_ffn), shift_fc, scale_fc)
    f = hier_moe(jnp.concatenate([hfc, hf], axis=1), w_rg, b_rg, w_re, b_re, w_gate, w_up, w_down)
    return x + gate_f * f[:, Lc:], xc + gate_fc * f[:, :Lc]


def setup_inputs(seed: int = 0) -> dict:
    key = jax.random.key(seed)
    ks = jax.random.split(key, 26)

    def nrm(k, shape, fan_in, gain=1.0):
        return jax.random.normal(k, shape, jnp.float32) * (gain * fan_in ** -0.5)

    def gains(k, shape):
        return 1.0 + 0.05 * jax.random.normal(k, shape, jnp.float32)

    def small(k, shape, s=0.01):
        return s * jax.random.normal(k, shape, jnp.float32)

    L = DEPTH
    return {
        'x': jax.random.normal(ks[0], (BATCH, SEQ, D_MODEL), jnp.float32),
        'c': jax.random.normal(ks[1], (BATCH, D_MODEL), jnp.float32),
        'ctx': jax.random.normal(ks[2], (BATCH, CTX_LEN, D_MODEL), jnp.float32),
        'c_ctx': jax.random.normal(ks[3], (D_MODEL,), jnp.float32),
        'w_ada': nrm(ks[4], (L, D_MODEL, 6 * D_MODEL), D_MODEL, 0.5),
        'b_ada': small(ks[5], (L, 6 * D_MODEL), 0.02),
        'g_attn': gains(ks[6], (L, D_MODEL)),
        'g_ffn': gains(ks[7], (L, D_MODEL)),
        'w_in': nrm(ks[8], (L, D_MODEL, IN_COLS), D_MODEL),
        'g_q': gains(ks[9], (L, Q_LORA)),
        'w_uq': nrm(ks[10], (L, Q_LORA, MLA_HEADS * (QK_NOPE + QK_ROPE)), Q_LORA),
        'g_kv': gains(ks[11], (L, KV_LORA)),
        'w_ukv': nrm(ks[12], (L, KV_LORA, MLA_HEADS * (QK_NOPE + V_DIM)), KV_LORA),
        'w_fnet': nrm(ks[13], (L, FNET_WIDTH, FNET_WIDTH), FNET_WIDTH),
        'b_fnet': small(ks[14], (L, FNET_WIDTH)),
        'na_rpb': small(ks[15], (L, NA_HEADS, 2 * NA_KH_MAX - 1, 2 * NA_KW - 1), 0.2),
        'g_out': gains(ks[16], (L, MIX_WIDTH)),
        'w_out': nrm(ks[17], (L, MIX_WIDTH, D_MODEL), MIX_WIDTH),
        'w_rg': nrm(ks[18], (L, D_MODEL, N_GROUPS), D_MODEL),
        'b_rg': small(ks[19], (L, N_GROUPS)),
        'w_re': nrm(ks[20], (L, D_MODEL, N_EXPERTS), D_MODEL),
        'b_re': small(ks[21], (L, N_EXPERTS)),
        'w_gate': nrm(ks[22], (L, N_GROUPS, EXPERTS_PER_GROUP, D_MODEL, D_EXPERT), D_MODEL),
        'w_up': nrm(ks[23], (L, N_GROUPS, EXPERTS_PER_GROUP, D_MODEL, D_EXPERT), D_MODEL),
        'w_down': nrm(ks[24], (L, N_GROUPS, EXPERTS_PER_GROUP, D_EXPERT, D_MODEL), D_EXPERT),
        'g_final': gains(ks[25], (D_MODEL,)),
    }


def reference(x, c, ctx, c_ctx, w_ada, b_ada, g_attn, g_ffn, w_in, g_q, w_uq, g_kv, w_ukv,
              w_fnet, b_fnet, na_rpb, g_out, w_out, w_rg, b_rg, w_re, b_re, w_gate, w_up, w_down,
              g_final):
    rope = axial_rope(x.shape[1])
    xc = ctx
    for l in range(DEPTH):
        x, xc = layer(x, xc, c, c_ctx, w_ada[l], b_ada[l], g_attn[l], g_ffn[l], w_in[l],
                      g_q[l], w_uq[l], g_kv[l], w_ukv[l], w_fnet[l], b_fnet[l], na_rpb[l],
                      g_out[l], w_out[l], w_rg[l], b_rg[l], w_re[l], b_re[l],
                      w_gate[l], w_up[l], w_down[l], rope, l < DEPTH - 1)
    return rmsnorm(x, g_final)
```

```cpp
#include <hip/hip_runtime.h>
#include <cstdio>
#include <cstdint>

#ifndef ONE_LAUNCH
#define ONE_LAUNCH 1
#endif

#define LAS __attribute__((address_space(3)))
typedef unsigned short bf16_t;
typedef float f32x4 __attribute__((ext_vector_type(4)));
typedef unsigned u32x4 __attribute__((ext_vector_type(4)));
typedef unsigned u32x2 __attribute__((ext_vector_type(2)));

constexpr int DM = 2048, NB = 4, SEQ = 2048, CTXL = 256, NLAYER = 2;
constexpr int T = NB * SEQ, TC = NB * CTXL, MT = T + TC;
constexpr int GW = 64;
constexpr int QL = 512, KVL = 256, KRD = 64, FW = 512, NAW = 512, INC = 2880;
constexpr int NH = 8, DQK = 192, DNOPE = 128, DV = 128, NAH = 4, NAD = 128;
constexpr int NGRP = 4, EPG = 8, NEXP = 32, DE = 512;
constexpr int C_ZQ = 0, C_ZKV = 512, C_ZKR = 768, C_ZF = 832, C_NAQ = 1344, C_NAK = 1856, C_NAV = 2368;
constexpr float EPS = 1e-6f;
constexpr int SLOTS = 26624;

constexpr size_t al256(size_t x) { return (x + 255) & ~(size_t)255; }
constexpr size_t CTL_BYTES = 2u << 20;
constexpr int CW_BAR = 4096;
constexpr int CW_CNT = 65536;
constexpr size_t CB_MOD = 1u << 20;
constexpr size_t O_ROPE = CTL_BYTES;
constexpr size_t O_COSL = O_ROPE + (size_t)SEQ * 32 * 2 * 4;
constexpr size_t O_WF   = al256(O_COSL + SEQ * 4);
constexpr size_t O_SSQ  = O_WF + (size_t)2 * 1024 * 512 * 4;
constexpr size_t O_RTE  = O_SSQ + (size_t)MT * 96 * 4;
constexpr size_t O_LIST = O_RTE + (size_t)2 * MT * 4 * 4;
constexpr size_t O_LW   = O_LIST + (size_t)2 * 32 * MT * 4;
constexpr size_t O_H    = al256(O_LW + (size_t)2 * 32 * MT * 4);
constexpr size_t O_XB   = O_H + (size_t)MT * DM * 2;
constexpr size_t O_HB   = O_XB + (size_t)MT * DM * 4;
constexpr size_t O_ZQ   = O_HB + (size_t)SLOTS * DE * 2;
constexpr size_t O_ZKV  = O_ZQ + (size_t)MT * QL * 2;
constexpr size_t O_KR   = O_ZKV + (size_t)MT * KVL * 2;
constexpr size_t O_ZF   = O_KR + (size_t)MT * KRD * 2;
constexpr size_t O_NAQ  = O_ZF + (size_t)MT * FW * 2;
constexpr size_t O_NAK  = O_NAQ + (size_t)MT * NAW * 2;
constexpr size_t O_NAV  = O_NAK + (size_t)MT * NAW * 2;
constexpr size_t O_QB   = O_NAV + (size_t)MT * NAW * 2;
constexpr size_t O_KN   = O_QB + (size_t)MT * NH * DQK * 2;
constexpr size_t O_VB   = O_KN + (size_t)MT * NH * DNOPE * 2;
constexpr size_t O_UVL  = O_VB + (size_t)MT * NH * DV * 2;
constexpr size_t O_UVC  = O_UVL + (size_t)NB * 512 * 4096 * 2;
constexpr size_t O_OM   = O_UVC + (size_t)NB * 512 * 512 * 2;
constexpr size_t O_OF   = O_OM + (size_t)MT * 1024 * 2;
constexpr size_t O_ON   = O_OF + (size_t)MT * FW * 4;
constexpr size_t O_Y    = O_ON + (size_t)MT * NAW * 2;
constexpr size_t O_ACT_END = O_Y + (size_t)MT * DM * 2;
constexpr size_t O_YE   = O_ZQ;
static_assert(O_YE + (size_t)SLOTS * DM * 2 <= O_ACT_END, "YE overlay");
constexpr size_t WS_END = O_ACT_END;

constexpr int LDS_BYTES = 147456;
constexpr int LDS_MISC = 147456 - 256;

__device__ __forceinline__ float bf2f(bf16_t b) { return __uint_as_float(((unsigned)b) << 16); }
__device__ __forceinline__ bf16_t f2bf(float f) { unsigned u = __float_as_uint(f); u += 0x7fffu + ((u >> 16) & 1u); return (bf16_t)(u >> 16); }
__device__ __forceinline__ unsigned pk2(float lo, float hi) { return (unsigned)f2bf(lo) | ((unsigned)f2bf(hi) << 16); }
__device__ __forceinline__ float wave_sum(float v) {
#pragma unroll
    for (int o = 1; o < 64; o <<= 1) v += __shfl_xor(v, o);
    return v;
}
__device__ __forceinline__ float wave_max(float v) {
#pragma unroll
    for (int o = 1; o < 64; o <<= 1) v = fmaxf(v, __shfl_xor(v, o));
    return v;
}
__device__ __forceinline__ float silu(float x) { return x / (1.0f + __expf(-x)); }

#define XB_TMO      128
#define XB_XCNT(j)  (256  + 64 * (j))
#define XB_XSUB(j)  (1280 + 64 * (j))
#define XB_XGEN(j)  (2304 + 64 * (j))
#define XB_TOP      3328
#define XB_TOPGEN   3392
#define XCD_BAR_WORDS 3456
#define XB_SPIN_CAP (1u << 18)

__device__ __forceinline__ unsigned xb_ld(unsigned* p)              { return __hip_atomic_load(p, __ATOMIC_RELAXED, __HIP_MEMORY_SCOPE_AGENT); }
__device__ __forceinline__ unsigned xb_add(unsigned* p, unsigned v) { return __hip_atomic_fetch_add(p, v, __ATOMIC_RELAXED, __HIP_MEMORY_SCOPE_AGENT); }
__device__ __forceinline__ unsigned xb_xcc_id() { return (unsigned)__builtin_amdgcn_s_getreg((3 << 11) | 20) & 0xFu; }
#define XB_SPIN(cond, bar) do { unsigned _sp = 0; while (cond) { __builtin_amdgcn_s_sleep(1); \
    if ((++_sp & 255u) == 0u) { if (xb_ld(&(bar)[XB_TMO])) break; if (_sp > XB_SPIN_CAP) { atomicAdd(&(bar)[XB_TMO], 1u); break; } } } } while (0)

struct XcdBarrier { unsigned* bar; unsigned x; volatile LAS unsigned* st; };

__device__ __forceinline__ XcdBarrier xcd_barrier_post(unsigned* bar, volatile LAS unsigned* st) {
    XcdBarrier b; b.bar = bar; b.x = xb_xcc_id(); b.st = st;
    if (threadIdx.x == 0) (void)xb_add(&bar[XB_XCNT(b.x)], 1u);
    return b;
}
__device__ __forceinline__ void xcd_barrier_complete(unsigned* bar, unsigned x, unsigned& nloc, unsigned& nx) {
    const unsigned G = gridDim.x * gridDim.y * gridDim.z;
    unsigned sum, cnt, mine, sp = 0u;
    for (;;) {
        sum = 0u; cnt = 0u; mine = 0u;
#pragma unroll
        for (unsigned j = 0; j < 16; ++j) { const unsigned c = xb_ld(&bar[XB_XCNT(j)]); sum += c; cnt += (c > 0u) ? 1u : 0u; mine = (j == x) ? c : mine; }
        if (sum == G) break;
        __builtin_amdgcn_s_sleep(1);
        if ((++sp & 255u) == 0u) { if (xb_ld(&bar[XB_TMO])) break; if (sp > XB_SPIN_CAP) { atomicAdd(&bar[XB_TMO], 1u); break; } }
    }
    nloc = mine > 0u ? mine : 1u; nx = cnt > 0u ? cnt : 1u;
}
__device__ __forceinline__ void xcd_barrier(const XcdBarrier& b) {
    asm volatile("s_waitcnt vmcnt(0)" ::: "memory");
    __syncthreads();
    if (threadIdx.x == 0) {
        unsigned* bar = b.bar;
        __builtin_amdgcn_s_waitcnt(0);
        unsigned nloc = b.st[0], nx = b.st[1];
        if (nloc == 0u) { xcd_barrier_complete(bar, b.x, nloc, nx); b.st[0] = nloc; b.st[1] = nx; }
        const unsigned old = xb_add(&bar[XB_XSUB(b.x)], 1u);
        const unsigned gen = old / nloc;
        if (old + 1u == (gen + 1u) * nloc) {
            __builtin_amdgcn_fence(__ATOMIC_RELEASE, "agent");
            asm volatile("s_waitcnt vmcnt(0)" ::: "memory");
            const unsigned og = xb_add(&bar[XB_TOP], 1u);
            const unsigned tg = og / nx;
            if (og + 1u == (tg + 1u) * nx) xb_add(&bar[XB_TOPGEN], 1u);
            else XB_SPIN(xb_ld(&bar[XB_TOPGEN]) == tg, bar);
            __builtin_amdgcn_fence(__ATOMIC_ACQUIRE, "agent");
            xb_add(&bar[XB_XGEN(b.x)], 1u);
            asm volatile("s_waitcnt vmcnt(0)" ::: "memory");
        } else {
            XB_SPIN(xb_ld(&bar[XB_XGEN(b.x)]) == gen, bar);
            __builtin_amdgcn_fence(__ATOMIC_ACQUIRE, "agent");
            asm volatile("s_waitcnt vmcnt(0)" ::: "memory");
        }
    }
    __syncthreads();
}

struct Params { const float* in[26]; float* out; unsigned char* ws; int ph_lo, ph_hi; };
enum { I_X = 0, I_C, I_CTX, I_CCTX, I_WADA, I_BADA, I_GATTN, I_GFFN, I_WIN, I_GQ, I_WUQ, I_GKV, I_WUKV, I_WFNET, I_BFNET, I_RPB, I_GOUT, I_WOUT,
       I_WRG, I_BRG, I_WRE, I_BRE, I_WGATE, I_WUP, I_WDOWN, I_GFINAL };

__device__ __forceinline__ const float* modp(const Params& p, int l, int b, int which) { return (const float*)(p.ws + CB_MOD) + ((size_t)(l * 5 + b) * 6 + which) * DM; }
__device__ __forceinline__ int row_batch(int r) { return r < T ? (r >> 11) : 4; }

template <bool BT, class AF, class BF, class EF>
__device__ __forceinline__ void sgemm_tile(float* lds, int m0, int n0, int M, int N, int K, const AF& af, const BF& bf, const EF& ef) {
    float* As = lds; float* Bs = lds + 16 * 132;
    const int tid = threadIdx.x, ty = tid >> 4, tx = tid & 15;
    float acc[4][8];
#pragma unroll
    for (int i = 0; i < 4; ++i)
#pragma unroll
        for (int j = 0; j < 8; ++j) acc[i][j] = 0.f;
    for (int k0 = 0; k0 < K; k0 += 16) {
#pragma unroll
        for (int i = 0; i < 4; ++i) { const int e = tid + i * 512, row = e >> 4, kk = e & 15; float v = 0.f; if (m0 + row < M) v = af(m0 + row, k0 + kk); As[kk * 132 + row] = v; }
#pragma unroll
        for (int i = 0; i < 4; ++i) { const int e = tid + i * 512; int kk, col; if (BT) { col = e >> 4; kk = e & 15; } else { kk = e >> 7; col = e & 127; }
            float v = 0.f; if (n0 + col < N) v = bf(k0 + kk, n0 + col); Bs[kk * 132 + col] = v; }
        __syncthreads();
#pragma unroll 2
        for (int kk = 0; kk < 16; ++kk) {
            const f32x4 a = *(const f32x4*)&As[kk * 132 + ty * 4];
            const f32x4 b0 = *(const f32x4*)&Bs[kk * 132 + tx * 8], b1 = *(const f32x4*)&Bs[kk * 132 + tx * 8 + 4];
#pragma unroll
            for (int i = 0; i < 4; ++i) {
#pragma unroll
                for (int j = 0; j < 4; ++j) { acc[i][j] = fmaf(a[i], b0[j], acc[i][j]); acc[i][4 + j] = fmaf(a[i], b1[j], acc[i][4 + j]); }
            }
        }
        __syncthreads();
    }
#pragma unroll
    for (int i = 0; i < 4; ++i) { const int row = m0 + ty * 4 + i; if (row < M && n0 + tx * 8 < N) ef(row, n0 + tx * 8, acc[i]); }
}
template <bool BT, class AF, class BF, class EF>
__device__ __forceinline__ void sgemm_phase(float* lds, int M, int N, int K, const AF& af, const BF& bf, const EF& ef) {
    const int tm = (M + 127) / 128, tn = (N + 127) / 128;
    for (int t = blockIdx.x; t < tm * tn; t += gridDim.x) sgemm_tile<BT>(lds, (t / tn) * 128, (t % tn) * 128, M, N, K, af, bf, ef);
}

template <int DK1, int DK2, class CF, class BiasF>
__device__ __forceinline__ void naive_attn_row(const bf16_t* q, float scale, int nkeys, const CF& chunk, const BiasF& bias, bf16_t* out, float* qs, int lane) {
    for (int d = lane; d < DK1 + DK2; d += 64) qs[d] = bf2f(q[d]);
    __builtin_amdgcn_wave_barrier();
    asm volatile("s_waitcnt lgkmcnt(0)" ::: "memory");
    float m = -3.0e38f, l = 0.f, o0 = 0.f, o1 = 0.f;
    for (int kt = 0; kt < nkeys; kt += 64) {
        const bf16_t *kn, *kr, *v; int kns, krs, vs;
        chunk(kt, kn, kns, kr, krs, v, vs);
        const bf16_t* k1 = kn + (size_t)lane * kns;
        float s = 0.f;
#pragma unroll 4
        for (int d = 0; d < DK1; d += 8) { const u32x4 w = *(const u32x4*)(k1 + d);
            s += qs[d] * __uint_as_float(w.x << 16) + qs[d + 1] * __uint_as_float(w.x & 0xffff0000u) + qs[d + 2] * __uint_as_float(w.y << 16) + qs[d + 3] * __uint_as_float(w.y & 0xffff0000u)
               + qs[d + 4] * __uint_as_float(w.z << 16) + qs[d + 5] * __uint_as_float(w.z & 0xffff0000u) + qs[d + 6] * __uint_as_float(w.w << 16) + qs[d + 7] * __uint_as_float(w.w & 0xffff0000u); }
        if (DK2 > 0) { const bf16_t* k2 = kr + (size_t)lane * krs;
#pragma unroll 4
            for (int d = 0; d < DK2; d += 8) { const u32x4 w = *(const u32x4*)(k2 + d); const float* qq = qs + DK1 + d;
                s += qq[0] * __uint_as_float(w.x << 16) + qq[1] * __uint_as_float(w.x & 0xffff0000u) + qq[2] * __uint_as_float(w.y << 16) + qq[3] * __uint_as_float(w.y & 0xffff0000u)
                   + qq[4] * __uint_as_float(w.z << 16) + qq[5] * __uint_as_float(w.z & 0xffff0000u) + qq[6] * __uint_as_float(w.w << 16) + qq[7] * __uint_as_float(w.w & 0xffff0000u); } }
        s = s * scale + bias(kt + lane);
        const float mn = fmaxf(m, wave_max(s));
        const float pj = __expf(s - mn), alpha = __expf(m - mn);
        l = l * alpha + wave_sum(pj); o0 *= alpha; o1 *= alpha; m = mn;
        for (int j = 0; j < 64; ++j) { const float pv = __shfl(pj, j); const bf16_t* vr = v + (size_t)j * vs; o0 = fmaf(pv, bf2f(vr[lane]), o0); o1 = fmaf(pv, bf2f(vr[lane + 64]), o1); }
    }
    const float rl = 1.0f / l;
    out[lane] = f2bf(o0 * rl); out[lane + 64] = f2bf(o1 * rl);
}

#define DEFPTRS unsigned char* ws = p.ws; asm volatile("" : "+s"(ws)); unsigned* ctl = (unsigned*)ws; (void)ctl; \
    float* MOD = (float*)(ws + CB_MOD); \
    float* ROPE = (float*)(ws + O_ROPE); float* COSL = (float*)(ws + O_COSL); float* WF = (float*)(ws + O_WF); float* SSQ = (float*)(ws + O_SSQ); \
    int* RTE = (int*)(ws + O_RTE); int* LIST = (int*)(ws + O_LIST); float* LW = (float*)(ws + O_LW); \
    bf16_t* H = (bf16_t*)(ws + O_H); float* XB = (float*)(ws + O_XB); bf16_t* HB = (bf16_t*)(ws + O_HB); \
    bf16_t* ZQ = (bf16_t*)(ws + O_ZQ); bf16_t* ZKV = (bf16_t*)(ws + O_ZKV); bf16_t* KR = (bf16_t*)(ws + O_KR); bf16_t* ZF = (bf16_t*)(ws + O_ZF); \
    bf16_t* NAQ = (bf16_t*)(ws + O_NAQ); bf16_t* NAK = (bf16_t*)(ws + O_NAK); bf16_t* NAV = (bf16_t*)(ws + O_NAV); \
    bf16_t* QB = (bf16_t*)(ws + O_QB); bf16_t* KN = (bf16_t*)(ws + O_KN); bf16_t* VB = (bf16_t*)(ws + O_VB); \
    bf16_t* UVL = (bf16_t*)(ws + O_UVL); bf16_t* UVC = (bf16_t*)(ws + O_UVC); \
    bf16_t* OM = (bf16_t*)(ws + O_OM); float* OF = (float*)(ws + O_OF); bf16_t* ON = (bf16_t*)(ws + O_ON); bf16_t* Y = (bf16_t*)(ws + O_Y); bf16_t* YE = (bf16_t*)(ws + O_YE);
__global__ void __launch_bounds__(512, 2) fwd_kernel(Params p) {
    extern __shared__ __attribute__((aligned(16))) unsigned char lds_raw[];
    float* ldsf = (float*)lds_raw;
    const int tid = threadIdx.x, lane = tid & 63, wave = tid >> 6;
    const int gw = blockIdx.x * 8 + wave, NGW = gridDim.x * 8;
    volatile LAS unsigned* misc = (volatile LAS unsigned*)((LAS unsigned char*)lds_raw + LDS_MISC);
    if (tid < 64) misc[tid] = 0u;
    __syncthreads();
    XcdBarrier bar; bar.bar = (unsigned*)p.ws + CW_BAR; bar.x = 0; bar.st = misc;
    if (p.ph_hi - p.ph_lo > 1) bar = xcd_barrier_post((unsigned*)p.ws + CW_BAR, misc);

    int ph = 0;
#define PHASE_BEGIN if (ph >= p.ph_lo && ph < p.ph_hi) { DEFPTRS
#define LAYERPTRS const float* g_attn = p.in[I_GATTN] + l * DM; const float* g_ffn = p.in[I_GFFN] + l * DM; (void)g_attn; (void)g_ffn; \
    int* cnt = (int*)(ctl + CW_CNT) + l * 32 * 64; int* rte = RTE + (size_t)l * MT * 4; int* list = LIST + (size_t)l * 32 * MT; float* lw = LW + (size_t)l * 32 * MT; (void)cnt; (void)rte; (void)list; (void)lw;
#define PHASE_END   if (ph + 1 < p.ph_hi) xcd_barrier(bar); } ++ph;

    PHASE_BEGIN
    {
        float* sl = ldsf;
        for (int task = blockIdx.x; task < 2 * 16 * 24; task += gridDim.x) {
            const int l = task / (16 * 24), r = task % (16 * 24), ks = r / 24, nb = r % 24, k0 = ks * 128, n = nb * 512 + tid;
            __syncthreads();
            for (int i = tid; i < 5 * 128; i += 512) { const int rr = i / 128, kk = i % 128; const float cv = rr < 4 ? p.in[I_C][rr * DM + k0 + kk] : p.in[I_CCTX][k0 + kk]; sl[i] = silu(cv); }
            __syncthreads();
            float a0 = 0.f, a1 = 0.f, a2 = 0.f, a3 = 0.f, a4 = 0.f;
            const float* w = p.in[I_WADA] + ((size_t)l * DM + k0) * (6 * DM) + n;
            for (int kk = 0; kk < 128; ++kk) { const float wv = w[(size_t)kk * (6 * DM)]; a0 = fmaf(sl[kk], wv, a0); a1 = fmaf(sl[128 + kk], wv, a1); a2 = fmaf(sl[256 + kk], wv, a2); a3 = fmaf(sl[384 + kk], wv, a3); a4 = fmaf(sl[512 + kk], wv, a4); }
            if (ks == 0) { const float bv = p.in[I_BADA][l * 6 * DM + n]; a0 += bv; a1 += bv; a2 += bv; a3 += bv; a4 += bv; }
            float* mo = XB + (size_t)ks * (2 * 5 * 6 * DM) + (size_t)(l * 5) * (6 * DM) + n;
            mo[0] = a0; mo[6 * DM] = a1; mo[12 * DM] = a2; mo[18 * DM] = a3; mo[24 * DM] = a4;
        }
        const int gt = blockIdx.x * 512 + tid, NT_ = gridDim.x * 512;
        for (int i = gt; i < SEQ * 32; i += NT_) { const int s = i >> 5, j = i & 31; const float invf = powf(10000.0f, -(float)(2 * (j & 15)) / 32.0f);
            const float pos = (float)(j < 16 ? (s >> 6) : (s & 63)); const float ang = pos * invf; ROPE[2 * i] = cosf(ang); ROPE[2 * i + 1] = sinf(ang); }
        for (int i = gt; i < SEQ; i += NT_) COSL[i] = cospif((float)i * (2.0f / (float)SEQ));
        for (int i = gt; i < 2 * 1024 * 512; i += NT_) { const int l = i >> 19, r = i & ((1 << 19) - 1), k = r >> 10, j = r & 1023, g = k >> 7, c = k & 127, jj = j & 511;
            const float* wf = p.in[I_WFNET] + ((size_t)l * FW + g * 128) * FW + jj; float a = 0.f;
            for (int m = 0; m < 128; ++m) { const int ph_ = (m * c) & 127; const float tv = (j < 512) ? cospif((float)ph_ * (1.0f / 64.0f)) : sinpif((float)ph_ * (1.0f / 64.0f)); a = fmaf(tv, wf[(size_t)m * FW], a); }
            WF[((size_t)l * 1024 + j) * 512 + k] = a; }
    }
    PHASE_END
    PHASE_BEGIN
    {
        for (int i = blockIdx.x * 512 + tid; i < 2 * 5 * 6 * DM; i += gridDim.x * 512) { float a = 0.f;
#pragma unroll
            for (int ks = 0; ks < 16; ++ks) a += XB[(size_t)ks * (2 * 5 * 6 * DM) + i];
            MOD[i] = a; }
    }
    PHASE_END

    for (int l = 0; l < NLAYER; ++l) {
        const bool ctx_out = (l < NLAYER - 1);

        PHASE_BEGIN
        {   LAYERPTRS
            int* pcnt = (int*)(ctl + CW_CNT) + (l - 1) * 32 * 64; const int* prte = RTE + (size_t)(l - 1) * MT * 4;
            for (int r = gw; r < MT; r += NGW) {
                const int b = row_batch(r);
                const float* src = (l == 0) ? (r < T ? p.in[I_X] + (size_t)r * DM : p.in[I_CTX] + (size_t)(r - T) * DM) : XB + (size_t)r * DM;
                f32x4 v[8]; float ss = 0.f;
#pragma unroll
                for (int j = 0; j < 8; ++j) v[j] = *(const f32x4*)(src + 4 * lane + 256 * j);
                if (l > 0) {
                    int c_ = lane < 32 ? pcnt[lane * 64] : 0; int padded = (c_ + 255) & ~255; int incl = padded;
#pragma unroll
                    for (int o = 1; o < 32; o <<= 1) { const int t_ = __shfl_up(incl, o); if (lane >= o) incl += t_; }
                    const int base_l = incl - padded;
                    const int e1 = prte[r * 4 + 0], p1 = prte[r * 4 + 1], e2 = prte[r * 4 + 2], p2 = prte[r * 4 + 3];
                    const int s1 = __shfl(base_l, e1) + p1, s2 = __shfl(base_l, e2) + p2;
                    const float* gf = modp(p, l - 1, b, 5);
                    const bf16_t* y1 = YE + (size_t)s1 * DM; const bf16_t* y2 = YE + (size_t)s2 * DM;
#pragma unroll
                    for (int j = 0; j < 8; ++j) { const int c0 = 4 * lane + 256 * j; const u32x2 a = *(const u32x2*)(y1 + c0), bb = *(const u32x2*)(y2 + c0); const f32x4 g = *(const f32x4*)(gf + c0);
                        v[j].x += g.x * (__uint_as_float(a.x << 16) + __uint_as_float(bb.x << 16)); v[j].y += g.y * (__uint_as_float(a.x & 0xffff0000u) + __uint_as_float(bb.x & 0xffff0000u));
                        v[j].z += g.z * (__uint_as_float(a.y << 16) + __uint_as_float(bb.y << 16)); v[j].w += g.w * (__uint_as_float(a.y & 0xffff0000u) + __uint_as_float(bb.y & 0xffff0000u));
                        *(f32x4*)(XB + (size_t)r * DM + c0) = v[j]; }
                }
#pragma unroll
                for (int j = 0; j < 8; ++j) ss += v[j].x * v[j].x + v[j].y * v[j].y + v[j].z * v[j].z + v[j].w * v[j].w;
                const float rstd = rsqrtf(wave_sum(ss) * (1.0f / DM) + EPS);
                const float* sh = modp(p, l, b, 0); const float* sc = modp(p, l, b, 1);
#pragma unroll
                for (int j = 0; j < 8; ++j) { const int c0 = 4 * lane + 256 * j; const f32x4 g = *(const f32x4*)(g_attn + c0), s_ = *(const f32x4*)(sc + c0), h_ = *(const f32x4*)(sh + c0);
                    const f32x4 o = v[j] * rstd * g * (s_ + 1.0f) + h_; u32x2 w; w.x = pk2(o.x, o.y); w.y = pk2(o.z, o.w); *(u32x2*)(H + (size_t)r * DM + c0) = w; }
            }
        }
        PHASE_END

        PHASE_BEGIN
        {   LAYERPTRS
            const float* w_in = p.in[I_WIN] + (size_t)l * DM * INC;
            auto af = [&](int row, int k) { return bf2f(H[(size_t)row * DM + k]); };
            auto bf = [&](int k, int col) { return w_in[(size_t)k * INC + col]; };
            auto ef = [&](int row, int c0, const float (&v)[8]) {
                bf16_t* dst; float o[8];
#pragma unroll
                for (int j = 0; j < 8; ++j) o[j] = v[j];
                if (c0 < C_ZKV) { dst = ZQ + (size_t)row * QL + c0; float s = 0.f;
#pragma unroll
                    for (int j = 0; j < 8; ++j) s += v[j] * v[j]; SSQ[row * 96 + (c0 >> 3)] = s; }
                else if (c0 < C_ZKR) { dst = ZKV + (size_t)row * KVL + (c0 - C_ZKV); float s = 0.f;
#pragma unroll
                    for (int j = 0; j < 8; ++j) s += v[j] * v[j]; SSQ[row * 96 + (c0 >> 3)] = s; }
                else if (c0 < C_ZF) { dst = KR + (size_t)row * KRD + (c0 - C_ZKR);
                    if (row < T) { const float* rp = ROPE + ((size_t)(row & (SEQ - 1)) * 32 + ((c0 - C_ZKR) >> 1)) * 2;
#pragma unroll
                        for (int j = 0; j < 4; ++j) { const float cs = rp[2 * j], sn = rp[2 * j + 1]; o[2 * j] = v[2 * j] * cs - v[2 * j + 1] * sn; o[2 * j + 1] = v[2 * j] * sn + v[2 * j + 1] * cs; } } }
                else if (c0 < C_NAQ) dst = ZF + (size_t)row * FW + (c0 - C_ZF);
                else if (c0 < C_NAK) dst = NAQ + (size_t)row * NAW + (c0 - C_NAQ);
                else if (c0 < C_NAV) dst = NAK + (size_t)row * NAW + (c0 - C_NAK);
                else dst = NAV + (size_t)row * NAW + (c0 - C_NAV);
                u32x4 w; w.x = pk2(o[0], o[1]); w.y = pk2(o[2], o[3]); w.z = pk2(o[4], o[5]); w.w = pk2(o[6], o[7]); *(u32x4*)dst = w;
            };
            sgemm_phase<false>(ldsf, MT, INC, DM, af, bf, ef);
        }
        PHASE_END

        PHASE_BEGIN
        {   LAYERPTRS
            {
                const float* g_q = p.in[I_GQ] + l * QL; const float* w_uq = p.in[I_WUQ] + (size_t)l * QL * (NH * DQK);
                auto af = [&](int row, int k) { return bf2f(ZQ[(size_t)row * QL + k]) * g_q[k]; };
                auto bf = [&](int k, int col) { return w_uq[(size_t)k * (NH * DQK) + col]; };
                auto ef = [&](int row, int c0, const float (&v)[8]) {
                    float sq = 0.f; for (int i = 0; i < 64; ++i) sq += SSQ[row * 96 + i]; const float rstd = rsqrtf(sq * (1.0f / QL) + EPS); float o[8];
#pragma unroll
                    for (int j = 0; j < 8; ++j) o[j] = v[j] * rstd;
                    const int ch = c0 % DQK;
                    if (row < T && ch >= DNOPE) { const float* rp = ROPE + ((size_t)(row & (SEQ - 1)) * 32 + ((ch - DNOPE) >> 1)) * 2;
#pragma unroll
                        for (int j = 0; j < 4; ++j) { const float cs = rp[2 * j], sn = rp[2 * j + 1], x1 = o[2 * j], x2 = o[2 * j + 1]; o[2 * j] = x1 * cs - x2 * sn; o[2 * j + 1] = x1 * sn + x2 * cs; } }
                    u32x4 w; w.x = pk2(o[0], o[1]); w.y = pk2(o[2], o[3]); w.z = pk2(o[4], o[5]); w.w = pk2(o[6], o[7]); *(u32x4*)(QB + (size_t)row * (NH * DQK) + c0) = w;
                };
                sgemm_phase<false>(ldsf, ctx_out ? MT : T, NH * DQK, QL, af, bf, ef);
            }
            {
                const float* g_kv = p.in[I_GKV] + l * KVL; const float* w_ukv = p.in[I_WUKV] + (size_t)l * KVL * (NH * 256);
                auto af = [&](int row, int k) { return bf2f(ZKV[(size_t)row * KVL + k]) * g_kv[k]; };
                auto bf = [&](int k, int col) { return w_ukv[(size_t)k * (NH * 256) + col]; };
                auto ef = [&](int row, int c0, const float (&v)[8]) {
                    float sq = 0.f; for (int i = 64; i < 96; ++i) sq += SSQ[row * 96 + i]; const float rstd = rsqrtf(sq * (1.0f / KVL) + EPS);
                    const int h = c0 >> 8, c = c0 & 255;
                    bf16_t* dst = (c < 128) ? KN + ((size_t)row * NH + h) * DNOPE + c : VB + ((size_t)row * NH + h) * DV + (c - 128);
                    u32x4 w; w.x = pk2(v[0] * rstd, v[1] * rstd); w.y = pk2(v[2] * rstd, v[3] * rstd); w.z = pk2(v[4] * rstd, v[5] * rstd); w.w = pk2(v[6] * rstd, v[7] * rstd); *(u32x4*)dst = w;
                };
                sgemm_phase<false>(ldsf, MT, NH * 256, KVL, af, bf, ef);
            }
            {
                const float* wf = WF + (size_t)l * 1024 * 512;
                auto af = [&](int row, int k) { return wf[(size_t)row * 512 + k]; };
                auto bf = [&](int k, int col) { return bf2f(ZF[(size_t)col * FW + k]); };
                auto ef = [&](int j, int n0, const float (&v)[8]) {
                    bf16_t* dst;
                    if (n0 < T) { const int b = n0 >> 11, s = n0 & (SEQ - 1); dst = UVL + ((size_t)b * 512 + (j & 511)) * 4096 + (j >> 9) * SEQ + s; }
                    else { const int n1 = n0 - T, b = n1 >> 8, s = n1 & 255; dst = UVC + ((size_t)b * 512 + (j & 511)) * 512 + (j >> 9) * CTXL + s; }
                    u32x4 w; w.x = pk2(v[0], v[1]); w.y = pk2(v[2], v[3]); w.z = pk2(v[4], v[5]); w.w = pk2(v[6], v[7]); *(u32x4*)dst = w;
                };
                sgemm_phase<true>(ldsf, 1024, ctx_out ? MT : T, 512, af, bf, ef);
            }
            {
                const float* rpb = p.in[I_RPB] + (size_t)l * NAH * 15 * 31;
                float* qs = ldsf + wave * 256;
                const float sc = 0.08838834764831845f;
                for (int task = gw; task < T * NAH; task += NGW) {
                    const int row = task >> 2, h = task & 3, b = row >> 11, s = row & (SEQ - 1), r = s >> 6, cq = s & 63;
                    const int rs = min(max(r - 4, 0), 24), cs = min(max(cq - 8, 0), 48);
                    auto chunk = [&](int kt, const bf16_t*& kn, int& kns, const bf16_t*& kr, int& krs, const bf16_t*& v, int& vs) {
                        const int krow = (kt < CTXL) ? (T + b * CTXL + kt) : (b * SEQ + rs * 64 + (kt - CTXL));
                        kn = NAK + (size_t)krow * NAW + h * NAD; kns = NAW; kr = nullptr; krs = 0; v = NAV + (size_t)krow * NAW + h * NAD; vs = NAW; };
                    auto bias = [&](int key) { if (key < CTXL) return 0.f; const int jl = key - CTXL, kri = jl >> 6, ck = jl & 63;
                        if (ck < cs || ck >= cs + 16) return -1.0e30f; const int drow = rs + kri - r + 7, dcol = min(max(ck - cq + 15, 0), 30); return rpb[(h * 15 + drow) * 31 + dcol]; };
                    naive_attn_row<128, 0>(NAQ + (size_t)row * NAW + h * NAD, sc, CTXL + 512, chunk, bias, ON + (size_t)row * NAW + h * NAD, qs, lane);
                }
            }
        }
        PHASE_END

        PHASE_BEGIN
        {   LAYERPTRS
            float* qs = ldsf + wave * 256;
            const float msc = 0.07216878364870323f;
            for (int task = gw; task < T * NH; task += NGW) {
                const int row = task >> 3, h = task & 7, b = row >> 11;
                auto chunk = [&](int kt, const bf16_t*& kn, int& kns, const bf16_t*& kr, int& krs, const bf16_t*& v, int& vs) {
                    const int krow = (kt < CTXL) ? (T + b * CTXL + kt) : (b * SEQ + (kt - CTXL));
                    kn = KN + ((size_t)krow * NH + h) * DNOPE; kns = NH * DNOPE; kr = KR + (size_t)krow * KRD; krs = KRD; v = VB + ((size_t)krow * NH + h) * DV; vs = NH * DV; };
                auto bias = [&](int) { return 0.f; };
                naive_attn_row<128, 64>(QB + ((size_t)row * NH + h) * DQK, msc, CTXL + SEQ, chunk, bias, OM + (size_t)row * 1024 + h * DV, qs, lane);
            }
            if (ctx_out) {
                for (int task = gw; task < TC * NH; task += NGW) {
                    const int row = T + (task >> 3), h = task & 7, b = (task >> 3) >> 8;
                    auto chunk = [&](int kt, const bf16_t*& kn, int& kns, const bf16_t*& kr, int& krs, const bf16_t*& v, int& vs) {
                        const int krow = T + b * CTXL + kt;
                        kn = KN + ((size_t)krow * NH + h) * DNOPE; kns = NH * DNOPE; kr = KR + (size_t)krow * KRD; krs = KRD; v = VB + ((size_t)krow * NH + h) * DV; vs = NH * DV; };
                    auto bias = [&](int) { return 0.f; };
                    naive_attn_row<128, 64>(QB + ((size_t)row * NH + h) * DQK, msc, CTXL, chunk, bias, OM + (size_t)row * 1024 + h * DV, qs, lane);
                }
                for (int task = gw; task < TC * NAH; task += NGW) {
                    const int row = T + (task >> 2), h = task & 3, b = (task >> 2) >> 8;
                    auto chunk = [&](int kt, const bf16_t*& kn, int& kns, const bf16_t*& kr, int& krs, const bf16_t*& v, int& vs) {
                        const int krow = T + b * CTXL + kt;
                        kn = NAK + (size_t)krow * NAW + h * NAD; kns = NAW; kr = nullptr; krs = 0; v = NAV + (size_t)krow * NAW + h * NAD; vs = NAW; };
                    auto bias = [&](int) { return 0.f; };
                    naive_attn_row<128, 0>(NAQ + (size_t)row * NAW + h * NAD, 0.08838834764831845f, CTXL, chunk, bias, ON + (size_t)row * NAW + h * NAD, qs, lane);
                }
            }
            __syncthreads();
            const float* bfn = p.in[I_BFNET] + l * FW;
            for (int b = 0; b < NB; ++b) {
                auto af = [&](int k, int kk) { const int n = kk & (SEQ - 1); const int idx = (k * n) & (SEQ - 1); return kk < SEQ ? COSL[idx] : -COSL[(idx - SEQ / 4) & (SEQ - 1)]; };
                auto bf = [&](int kk, int j) { return bf2f(UVL[((size_t)b * 512 + j) * 4096 + kk]); };
                auto ef = [&](int k, int j0, const float (&v)[8]) { const float sc = 0.001953125f;
                    float* dst = OF + (size_t)(b * SEQ + k) * FW + j0;
#pragma unroll
                    for (int j = 0; j < 8; ++j) dst[j] = v[j] * sc + bfn[j0 + j]; };
                sgemm_phase<true>(ldsf, SEQ, FW, 2 * SEQ, af, bf, ef);
            }
            if (ctx_out) {
                for (int b = 0; b < NB; ++b) {
                    auto af = [&](int k, int kk) { const int n = kk & (CTXL - 1); const int idx = ((k * n) & (CTXL - 1)) * (SEQ / CTXL); return kk < CTXL ? COSL[idx] : -COSL[(idx - SEQ / 4) & (SEQ - 1)]; };
                    auto bf = [&](int kk, int j) { return bf2f(UVC[((size_t)b * 512 + j) * 512 + kk]); };
                    auto ef = [&](int k, int j0, const float (&v)[8]) { const float sc = 0.005524271728019903f;
                        float* dst = OF + (size_t)(T + b * CTXL + k) * FW + j0;
#pragma unroll
                        for (int j = 0; j < 8; ++j) dst[j] = v[j] * sc + bfn[j0 + j]; };
                    sgemm_phase<true>(ldsf, CTXL, FW, 2 * CTXL, af, bf, ef);
                }
            }
        }
        PHASE_END

        PHASE_BEGIN
        {   LAYERPTRS
            const float* g_out = p.in[I_GOUT] + l * DM;
            const int rows = ctx_out ? MT : T;
            for (int r = gw; r < rows; r += NGW) {
                float vm[16], vf[8], vn[8]; float s1 = 0.f, s2 = 0.f, s3 = 0.f;
#pragma unroll
                for (int j = 0; j < 4; ++j) { const u32x2 a = *(const u32x2*)(OM + (size_t)r * 1024 + 4 * lane + 256 * j); vm[4 * j] = __uint_as_float(a.x << 16); vm[4 * j + 1] = __uint_as_float(a.x & 0xffff0000u); vm[4 * j + 2] = __uint_as_float(a.y << 16); vm[4 * j + 3] = __uint_as_float(a.y & 0xffff0000u); }
#pragma unroll
                for (int j = 0; j < 2; ++j) { const f32x4 a = *(const f32x4*)(OF + (size_t)r * FW + 4 * lane + 256 * j); vf[4 * j] = a.x; vf[4 * j + 1] = a.y; vf[4 * j + 2] = a.z; vf[4 * j + 3] = a.w; }
#pragma unroll
                for (int j = 0; j < 2; ++j) { const u32x2 a = *(const u32x2*)(ON + (size_t)r * NAW + 4 * lane + 256 * j); vn[4 * j] = __uint_as_float(a.x << 16); vn[4 * j + 1] = __uint_as_float(a.x & 0xffff0000u); vn[4 * j + 2] = __uint_as_float(a.y << 16); vn[4 * j + 3] = __uint_as_float(a.y & 0xffff0000u); }
#pragma unroll
                for (int j = 0; j < 16; ++j) s1 += vm[j] * vm[j];
#pragma unroll
                for (int j = 0; j < 8; ++j) { s2 += vf[j] * vf[j]; s3 += vn[j] * vn[j]; }
                const float r1 = rsqrtf(wave_sum(s1) * (1.0f / 1024.0f) + EPS), r2 = rsqrtf(wave_sum(s2) * (1.0f / 512.0f) + EPS), r3 = rsqrtf(wave_sum(s3) * (1.0f / 512.0f) + EPS);
                bf16_t* yr = Y + (size_t)r * DM;
#pragma unroll
                for (int j = 0; j < 4; ++j) { const int c0 = 4 * lane + 256 * j; const f32x4 g = *(const f32x4*)(g_out + c0); u32x2 w; w.x = pk2(vm[4 * j] * r1 * g.x, vm[4 * j + 1] * r1 * g.y); w.y = pk2(vm[4 * j + 2] * r1 * g.z, vm[4 * j + 3] * r1 * g.w); *(u32x2*)(yr + c0) = w; }
#pragma unroll
                for (int j = 0; j < 2; ++j) { const int c0 = 4 * lane + 256 * j; const f32x4 g = *(const f32x4*)(g_out + 1024 + c0); u32x2 w; w.x = pk2(vf[4 * j] * r2 * g.x, vf[4 * j + 1] * r2 * g.y); w.y = pk2(vf[4 * j + 2] * r2 * g.z, vf[4 * j + 3] * r2 * g.w); *(u32x2*)(yr + 1024 + c0) = w; }
#pragma unroll
                for (int j = 0; j < 2; ++j) { const int c0 = 4 * lane + 256 * j; const f32x4 g = *(const f32x4*)(g_out + 1536 + c0); u32x2 w; w.x = pk2(vn[4 * j] * r3 * g.x, vn[4 * j + 1] * r3 * g.y); w.y = pk2(vn[4 * j + 2] * r3 * g.z, vn[4 * j + 3] * r3 * g.w); *(u32x2*)(yr + 1536 + c0) = w; }
            }
        }
        PHASE_END

        PHASE_BEGIN
        {   LAYERPTRS
            const float* w_out = p.in[I_WOUT] + (size_t)l * DM * DM;
            auto af = [&](int row, int k) { return bf2f(Y[(size_t)row * DM + k]); };
            auto bf = [&](int k, int col) { return w_out[(size_t)k * DM + col]; };
            auto ef = [&](int row, int c0, const float (&v)[8]) {
                const int b = row_batch(row); const float* ga = modp(p, l, b, 2) + c0;
                const float* xr = (l == 0) ? (row < T ? p.in[I_X] + (size_t)row * DM : p.in[I_CTX] + (size_t)(row - T) * DM) : XB + (size_t)row * DM;
                float* dst = XB + (size_t)row * DM + c0;
#pragma unroll
                for (int j = 0; j < 8; ++j) dst[j] = xr[c0 + j] + ga[j] * v[j];
            };
            sgemm_phase<false>(ldsf, ctx_out ? MT : T, DM, DM, af, bf, ef);
        }
        PHASE_END

        PHASE_BEGIN
        {   LAYERPTRS
            const float* w_rg = p.in[I_WRG] + (size_t)l * DM * NGRP; const float* b_rg = p.in[I_BRG] + l * NGRP;
            const float* w_re = p.in[I_WRE] + (size_t)l * DM * NEXP; const float* b_re = p.in[I_BRE] + l * NEXP;
            const int rows = ctx_out ? MT : T;
            for (int r = gw; r < rows; r += NGW) {
                const int b = row_batch(r);
                f32x4 v[8]; float ss = 0.f;
#pragma unroll
                for (int j = 0; j < 8; ++j) { v[j] = *(const f32x4*)(XB + (size_t)r * DM + 4 * lane + 256 * j); ss += v[j].x * v[j].x + v[j].y * v[j].y + v[j].z * v[j].z + v[j].w * v[j].w; }
                const float rstd = rsqrtf(wave_sum(ss) * (1.0f / DM) + EPS);
                const float* sh = modp(p, l, b, 3); const float* sc = modp(p, l, b, 4);
                float lg[4], le[32];
#pragma unroll
                for (int j = 0; j < 4; ++j) lg[j] = 0.f;
#pragma unroll
                for (int j = 0; j < 32; ++j) le[j] = 0.f;
#pragma unroll 1
                for (int j = 0; j < 8; ++j) { const int c0 = 4 * lane + 256 * j; const f32x4 g = *(const f32x4*)(g_ffn + c0), s_ = *(const f32x4*)(sc + c0), h_ = *(const f32x4*)(sh + c0);
                    const f32x4 o = v[j] * rstd * g * (s_ + 1.0f) + h_; u32x2 w; w.x = pk2(o.x, o.y); w.y = pk2(o.z, o.w); *(u32x2*)(H + (size_t)r * DM + c0) = w;
#pragma unroll 1
                    for (int t = 0; t < 4; ++t) { const float hv = o[t]; const f32x4 wg = *(const f32x4*)(w_rg + (size_t)(c0 + t) * NGRP);
                        lg[0] = fmaf(hv, wg.x, lg[0]); lg[1] = fmaf(hv, wg.y, lg[1]); lg[2] = fmaf(hv, wg.z, lg[2]); lg[3] = fmaf(hv, wg.w, lg[3]);
                        const f32x4* we = (const f32x4*)(w_re + (size_t)(c0 + t) * NEXP);
#pragma unroll
                        for (int q = 0; q < 8; ++q) { const f32x4 wv = we[q]; le[4 * q] = fmaf(hv, wv.x, le[4 * q]); le[4 * q + 1] = fmaf(hv, wv.y, le[4 * q + 1]); le[4 * q + 2] = fmaf(hv, wv.z, le[4 * q + 2]); le[4 * q + 3] = fmaf(hv, wv.w, le[4 * q + 3]); } } }
#pragma unroll
                for (int j = 0; j < 4; ++j) lg[j] = wave_sum(lg[j]) + b_rg[j];
#pragma unroll
                for (int j = 0; j < 32; ++j) le[j] = wave_sum(le[j]) + b_re[j];
                int gsel = 0; float mg = lg[0];
#pragma unroll
                for (int j = 1; j < 4; ++j) if (lg[j] > mg) { mg = lg[j]; gsel = j; }
                float sg = 0.f;
#pragma unroll
                for (int j = 0; j < 4; ++j) sg += __expf(lg[j] - mg);
                const float g_w = 1.0f / sg;
                float l8[8];
#pragma unroll
                for (int i = 0; i < 8; ++i) l8[i] = gsel == 0 ? le[i] : gsel == 1 ? le[8 + i] : gsel == 2 ? le[16 + i] : le[24 + i];
                int i1 = 0; float m1 = l8[0];
#pragma unroll
                for (int i = 1; i < 8; ++i) if (l8[i] > m1) { m1 = l8[i]; i1 = i; }
                int i2 = -1; float m2 = -3.0e38f;
#pragma unroll
                for (int i = 0; i < 8; ++i) if (i != i1 && l8[i] > m2) { m2 = l8[i]; i2 = i; }
                const float p2 = __expf(m2 - m1);
                const float w1 = g_w / (1.0f + p2), w2 = g_w * p2 / (1.0f + p2);
                if (lane == 0) {
                    const int e1 = gsel * 8 + i1, e2 = gsel * 8 + i2;
                    const int q1 = atomicAdd(&cnt[e1 * 64], 1), q2 = atomicAdd(&cnt[e2 * 64], 1);
                    list[(size_t)e1 * MT + q1] = r; lw[(size_t)e1 * MT + q1] = w1; list[(size_t)e2 * MT + q2] = r; lw[(size_t)e2 * MT + q2] = w2;
                    rte[r * 4 + 0] = e1; rte[r * 4 + 1] = q1; rte[r * 4 + 2] = e2; rte[r * 4 + 3] = q2;
                }
            }
        }
        PHASE_END

        PHASE_BEGIN
        {   LAYERPTRS
            int* s_base = (int*)(lds_raw + 65536);
            __syncthreads();
            if (tid == 0) { int a = 0; for (int e = 0; e < 32; ++e) { s_base[e] = a; a += (cnt[e * 64] + 255) & ~255; } s_base[32] = a; }
            __syncthreads();
            const float* w_gate = p.in[I_WGATE] + (size_t)l * NEXP * DM * DE; const float* w_up = p.in[I_WUP] + (size_t)l * NEXP * DM * DE;
            int tbase = 0;
            for (int e = 0; e < 32; ++e) {
                const int ce = cnt[e * 64], tm = (ce + 127) / 128, nt = tm * 8;
                const int* le_ = list + (size_t)e * MT; const float* lwe = lw + (size_t)e * MT; const int sb = s_base[e];
                const float* wg = w_gate + (size_t)e * DM * DE; const float* wu = w_up + (size_t)e * DM * DE;
                auto af = [&](int i, int k) { return bf2f(H[(size_t)le_[i] * DM + k]); };
                auto bf = [&](int k, int col) { return (col & 1) ? wu[(size_t)k * DE + (col >> 1)] : wg[(size_t)k * DE + (col >> 1)]; };
                auto ef = [&](int i, int c0, const float (&v)[8]) { const float w = lwe[i];
                    u32x2 o; o.x = pk2(silu(v[0]) * v[1] * w, silu(v[2]) * v[3] * w); o.y = pk2(silu(v[4]) * v[5] * w, silu(v[6]) * v[7] * w); *(u32x2*)(HB + (size_t)(sb + i) * DE + (c0 >> 1)) = o; };
                int first = ((int)blockIdx.x - tbase) % (int)gridDim.x; if (first < 0) first += gridDim.x;
                for (int t = first; t < nt; t += gridDim.x) sgemm_tile<false>(ldsf, (t >> 3) * 128, (t & 7) * 128, ce, 1024, DM, af, bf, ef);
                tbase += nt;
            }
        }
        PHASE_END

        PHASE_BEGIN
        {   LAYERPTRS
            int* s_base2 = (int*)(lds_raw + 65536);
            __syncthreads();
            if (tid == 0) { int a = 0; for (int e = 0; e < 32; ++e) { s_base2[e] = a; a += (cnt[e * 64] + 255) & ~255; } s_base2[32] = a; }
            __syncthreads();
            const float* w_down = p.in[I_WDOWN] + (size_t)l * NEXP * DE * DM;
            int tbase = 0;
            for (int e = 0; e < 32; ++e) {
                const int ce = cnt[e * 64], tm = (ce + 127) / 128, nt = tm * 16; const int sb = s_base2[e];
                const float* wd = w_down + (size_t)e * DE * DM;
                auto af = [&](int i, int k) { return bf2f(HB[(size_t)(sb + i) * DE + k]); };
                auto bf = [&](int k, int col) { return wd[(size_t)k * DM + col]; };
                auto ef = [&](int i, int c0, const float (&v)[8]) { u32x4 w; w.x = pk2(v[0], v[1]); w.y = pk2(v[2], v[3]); w.z = pk2(v[4], v[5]); w.w = pk2(v[6], v[7]); *(u32x4*)(YE + (size_t)(sb + i) * DM + c0) = w; };
                int first = ((int)blockIdx.x - tbase) % (int)gridDim.x; if (first < 0) first += gridDim.x;
                for (int t = first; t < nt; t += gridDim.x) sgemm_tile<false>(ldsf, (t >> 4) * 128, (t & 15) * 128, ce, DM, DE, af, bf, ef);
                tbase += nt;
            }
        }
        PHASE_END
    }

    PHASE_BEGIN
    {
        const int l = NLAYER - 1;
        int* pcnt = (int*)(ctl + CW_CNT) + l * 32 * 64; const int* prte = RTE + (size_t)l * MT * 4;
        const float* gfin = p.in[I_GFINAL];
        for (int r = gw; r < T; r += NGW) {
            const int b = row_batch(r);
            f32x4 v[8]; float ss = 0.f;
#pragma unroll
            for (int j = 0; j < 8; ++j) v[j] = *(const f32x4*)(XB + (size_t)r * DM + 4 * lane + 256 * j);
            int c_ = lane < 32 ? pcnt[lane * 64] : 0; int padded = (c_ + 255) & ~255; int incl = padded;
#pragma unroll
            for (int o = 1; o < 32; o <<= 1) { const int t_ = __shfl_up(incl, o); if (lane >= o) incl += t_; }
            const int base_l = incl - padded;
            const int e1 = prte[r * 4 + 0], p1 = prte[r * 4 + 1], e2 = prte[r * 4 + 2], p2 = prte[r * 4 + 3];
            const int s1 = __shfl(base_l, e1) + p1, s2 = __shfl(base_l, e2) + p2;
            const float* gf = modp(p, l, b, 5);
            const bf16_t* y1 = YE + (size_t)s1 * DM; const bf16_t* y2 = YE + (size_t)s2 * DM;
#pragma unroll
            for (int j = 0; j < 8; ++j) { const int c0 = 4 * lane + 256 * j; const u32x2 a = *(const u32x2*)(y1 + c0), bb = *(const u32x2*)(y2 + c0); const f32x4 g = *(const f32x4*)(gf + c0);
                v[j].x += g.x * (__uint_as_float(a.x << 16) + __uint_as_float(bb.x << 16)); v[j].y += g.y * (__uint_as_float(a.x & 0xffff0000u) + __uint_as_float(bb.x & 0xffff0000u));
                v[j].z += g.z * (__uint_as_float(a.y << 16) + __uint_as_float(bb.y << 16)); v[j].w += g.w * (__uint_as_float(a.y & 0xffff0000u) + __uint_as_float(bb.y & 0xffff0000u));
                ss += v[j].x * v[j].x + v[j].y * v[j].y + v[j].z * v[j].z + v[j].w * v[j].w; }
            const float rstd = rsqrtf(wave_sum(ss) * (1.0f / DM) + EPS);
#pragma unroll
            for (int j = 0; j < 8; ++j) { const int c0 = 4 * lane + 256 * j; const f32x4 g = *(const f32x4*)(gfin + c0); *(f32x4*)(p.out + (size_t)r * DM + c0) = v[j] * rstd * g; }
        }
    }
    PHASE_END
#undef PHASE_BEGIN
#undef PHASE_END
}

constexpr int NPHASES = 2 + 9 * NLAYER + 1;

extern "C" void kernel_launch(void* const* d_in, const int* in_sizes, int n_in, void* d_out, int out_size, void* d_ws, size_t ws_size, hipStream_t stream) {
    static int grid = 0;
    if (grid == 0) {
        if (n_in != 26 || out_size != T * DM || ws_size < WS_END) { fprintf(stderr, "kernel_launch: unexpected shapes (n_in %d out %d ws %zu need %zu)\n", n_in, out_size, ws_size, (size_t)WS_END); grid = -1; return; }
        int dev = 0, cus = 0, per_cu = 0;
        if (hipGetDevice(&dev) != hipSuccess || hipDeviceGetAttribute(&cus, hipDeviceAttributeMultiprocessorCount, dev) != hipSuccess) { grid = -1; return; }
        if (hipFuncSetAttribute((const void*)fwd_kernel, hipFuncAttributeMaxDynamicSharedMemorySize, LDS_BYTES) != hipSuccess) { fprintf(stderr, "kernel_launch: hipFuncSetAttribute failed\n"); grid = -1; return; }
        if (hipOccupancyMaxActiveBlocksPerMultiprocessor(&per_cu, (const void*)fwd_kernel, 512, LDS_BYTES) != hipSuccess || per_cu < 1) { fprintf(stderr, "kernel_launch: occupancy query says %d\n", per_cu); }
        (void)hipGetLastError();
        grid = cus;
    }
    if (grid < 0) return;
    (void)hipMemsetAsync(d_ws, 0, CTL_BYTES, stream);
    Params p{};
    for (int i = 0; i < 26; ++i) p.in[i] = (const float*)d_in[i];
    p.out = (float*)d_out; p.ws = (unsigned char*)d_ws;
#if ONE_LAUNCH
    p.ph_lo = 0; p.ph_hi = NPHASES;
    hipLaunchKernelGGL(fwd_kernel, dim3(grid), dim3(512), LDS_BYTES, stream, p);
#else
    for (int ph = 0; ph < NPHASES; ++ph) { p.ph_lo = ph; p.ph_hi = ph + 1; hipLaunchKernelGGL(fwd_kernel, dim3(grid), dim3(512), LDS_BYTES, stream, p); }
#endif
}
```

```cpp
#include <hip/hip_runtime.h>
#include <cstdio>
#include <cstdint>

#ifndef ONE_LAUNCH
#define ONE_LAUNCH 1
#endif

#ifndef OPT_L2
#define OPT_L2 1
#endif
#ifndef OPT_L3G
#define OPT_L3G 1
#endif
#ifndef OPT_F2
#define OPT_F2 1
#endif
#ifndef OPT_L6
#define OPT_L6 1
#endif
#ifndef OPT_MOE
#define OPT_MOE 1
#endif
#ifndef OPT_ATT
#define OPT_ATT 1
#endif
#define LAS __attribute__((address_space(3)))
typedef unsigned short bf16_t;
typedef float f32x4 __attribute__((ext_vector_type(4)));
typedef unsigned u32x4 __attribute__((ext_vector_type(4)));
typedef unsigned u32x2 __attribute__((ext_vector_type(2)));

constexpr int DM = 2048, NB = 4, SEQ = 2048, CTXL = 256, NLAYER = 2;
constexpr int T = NB * SEQ, TC = NB * CTXL, MT = T + TC;
constexpr int GW = 64;
constexpr int QL = 512, KVL = 256, KRD = 64, FW = 512, NAW = 512, INC = 2880;
constexpr int NH = 8, DQK = 192, DNOPE = 128, DV = 128, NAH = 4, NAD = 128;
constexpr int NGRP = 4, EPG = 8, NEXP = 32, DE = 512;
constexpr int C_ZQ = 0, C_ZKV = 512, C_ZKR = 768, C_ZF = 832, C_NAQ = 1344, C_NAK = 1856, C_NAV = 2368;
constexpr float EPS = 1e-6f;
constexpr int SLOTS = 26624;

constexpr size_t al256(size_t x) { return (x + 255) & ~(size_t)255; }
constexpr size_t CTL_BYTES = 2u << 20;
constexpr int CW_BAR = 4096;
constexpr int CW_CNT = 65536;
constexpr size_t CB_MOD = 1u << 20;
constexpr size_t O_ROPE = CTL_BYTES;
constexpr size_t O_COSL = O_ROPE + (size_t)SEQ * 32 * 2 * 4;
constexpr size_t O_WF   = al256(O_COSL + SEQ * 4);
constexpr size_t O_SSQ  = O_WF + (size_t)2 * 1024 * 512 * 4;
constexpr size_t O_RTE  = O_SSQ + (size_t)MT * 96 * 4;
constexpr size_t O_LIST = O_RTE + (size_t)2 * MT * 4 * 4;
constexpr size_t O_LW   = O_LIST + (size_t)2 * 32 * MT * 4;
constexpr size_t O_H    = al256(O_LW + (size_t)2 * 32 * MT * 4);
constexpr size_t O_XB   = O_H + (size_t)MT * DM * 2;
constexpr size_t O_HB   = O_XB + (size_t)MT * DM * 4;
constexpr size_t O_ZQ   = O_HB + (size_t)SLOTS * DE * 2;
constexpr size_t O_ZKV  = O_ZQ + (size_t)MT * QL * 2;
constexpr size_t O_KR   = O_ZKV + (size_t)MT * KVL * 2;
constexpr size_t O_ZF   = O_KR + (size_t)MT * KRD * 2;
constexpr size_t O_NAQ  = O_ZF + (size_t)MT * FW * 2;
constexpr size_t O_NAK  = O_NAQ + (size_t)MT * NAW * 2;
constexpr size_t O_NAV  = O_NAK + (size_t)MT * NAW * 2;
constexpr size_t O_QB   = O_NAV + (size_t)MT * NAW * 2;
constexpr size_t O_KN   = O_QB + (size_t)MT * NH * DQK * 2;
constexpr size_t O_VB   = O_KN + (size_t)MT * NH * DNOPE * 2;
constexpr size_t O_UVL  = O_VB + (size_t)MT * NH * DV * 2;
constexpr size_t O_UVC  = O_UVL + (size_t)NB * 512 * 4096 * 2;
constexpr size_t O_OM   = O_UVC + (size_t)NB * 512 * 512 * 2;
constexpr size_t O_OF   = O_OM + (size_t)MT * 1024 * 2;
constexpr size_t O_ON   = O_OF + (size_t)MT * FW * 4;
constexpr size_t O_Y    = O_ON + (size_t)MT * NAW * 2;
constexpr size_t O_ACT_END = O_Y + (size_t)MT * DM * 2;
constexpr size_t O_YE   = O_ZQ;
static_assert(O_YE + (size_t)SLOTS * DM * 2 <= O_ACT_END, "YE overlay");
constexpr size_t O_WIN  = al256(O_ACT_END);
constexpr size_t O_WUQ  = O_WIN + (size_t)2 * 3072 * 2048 * 2;
constexpr size_t O_WUKV = O_WUQ + (size_t)2 * 1536 * 512 * 2;
constexpr size_t O_WOUT = O_WUKV + (size_t)2 * 2048 * 256 * 2;
constexpr size_t O_WGU  = O_WOUT + (size_t)2 * 2048 * 2048 * 2;
constexpr size_t O_WD   = O_WGU + (size_t)2 * 32 * 1024 * 2048 * 2;
constexpr size_t O_WFA  = O_WD + (size_t)2 * 32 * 2048 * 512 * 2;
constexpr size_t O_DFTL = O_WFA + (size_t)2 * 1024 * 512 * 2;
constexpr size_t O_DFTC = O_DFTL + (size_t)2048 * 4096 * 2;
constexpr size_t WS_END = O_DFTC + (size_t)256 * 512 * 2;

constexpr int LDS_BYTES = 147456;
constexpr int LDS_MISC = 147456 - 256;

__device__ __forceinline__ float bf2f(bf16_t b) { return __uint_as_float(((unsigned)b) << 16); }
__device__ __forceinline__ bf16_t f2bf(float f) { unsigned u = __float_as_uint(f); u += 0x7fffu + ((u >> 16) & 1u); return (bf16_t)(u >> 16); }
__device__ __forceinline__ unsigned pk2(float lo, float hi) { return (unsigned)f2bf(lo) | ((unsigned)f2bf(hi) << 16); }
__device__ __forceinline__ int my_lane() { int l; asm volatile("v_mbcnt_lo_u32_b32 %0, -1, 0\n\tv_mbcnt_hi_u32_b32 %0, -1, %0" : "=v"(l)); return l; }
__device__ __forceinline__ float shx(float v, int mask, int lane) { return __int_as_float(__builtin_amdgcn_ds_bpermute((lane ^ mask) << 2, __float_as_int(v))); }
__device__ __forceinline__ float wave_sum(float v) {
    const int l = my_lane();
#pragma unroll
    for (int o = 1; o < 64; o <<= 1) v += shx(v, o, l);
    return v;
}
__device__ __forceinline__ float wave_max(float v) {
    const int l = my_lane();
#pragma unroll
    for (int o = 1; o < 64; o <<= 1) v = fmaxf(v, shx(v, o, l));
    return v;
}
__device__ __forceinline__ int wave_incl_scan32(int v, int lane) {
#pragma unroll
    for (int o = 1; o < 32; o <<= 1) { const int t_ = __builtin_amdgcn_ds_bpermute(((lane - o) & 63) << 2, v); if (lane >= o) v += t_; }
    return v;
}
__device__ __forceinline__ float silu(float x) { return x / (1.0f + __expf(-x)); }

#define XB_TMO      128
#define XB_XCNT(j)  (256  + 64 * (j))
#define XB_XSUB(j)  (1280 + 64 * (j))
#define XB_XGEN(j)  (2304 + 64 * (j))
#define XB_TOP      3328
#define XB_TOPGEN   3392
#define XCD_BAR_WORDS 3456
#define XB_SPIN_CAP (1u << 18)

__device__ __forceinline__ unsigned xb_ld(unsigned* p)              { return __hip_atomic_load(p, __ATOMIC_RELAXED, __HIP_MEMORY_SCOPE_AGENT); }
__device__ __forceinline__ unsigned xb_add(unsigned* p, unsigned v) { return __hip_atomic_fetch_add(p, v, __ATOMIC_RELAXED, __HIP_MEMORY_SCOPE_AGENT); }
__device__ __forceinline__ unsigned xb_xcc_id() { return (unsigned)__builtin_amdgcn_s_getreg((3 << 11) | 20) & 0xFu; }
#define XB_SPIN(cond, bar) do { unsigned _sp = 0; while (cond) { __builtin_amdgcn_s_sleep(1); \
    if ((++_sp & 255u) == 0u) { if (xb_ld(&(bar)[XB_TMO])) break; if (_sp > XB_SPIN_CAP) { atomicAdd(&(bar)[XB_TMO], 1u); break; } } } } while (0)

struct XcdBarrier { unsigned* bar; unsigned x; volatile LAS unsigned* st; };

__device__ __forceinline__ XcdBarrier xcd_barrier_post(unsigned* bar, volatile LAS unsigned* st) {
    XcdBarrier b; b.bar = bar; b.x = xb_xcc_id(); b.st = st;
    if (threadIdx.x == 0) (void)xb_add(&bar[XB_XCNT(b.x)], 1u);
    return b;
}
__device__ __forceinline__ void xcd_barrier_complete(unsigned* bar, unsigned x, unsigned& nloc, unsigned& nx) {
    const unsigned G = gridDim.x * gridDim.y * gridDim.z;
    unsigned sum, cnt, mine, sp = 0u;
    for (;;) {
        sum = 0u; cnt = 0u; mine = 0u;
#pragma unroll
        for (unsigned j = 0; j < 16; ++j) { const unsigned c = xb_ld(&bar[XB_XCNT(j)]); sum += c; cnt += (c > 0u) ? 1u : 0u; mine = (j == x) ? c : mine; }
        if (sum == G) break;
        __builtin_amdgcn_s_sleep(1);
        if ((++sp & 255u) == 0u) { if (xb_ld(&bar[XB_TMO])) break; if (sp > XB_SPIN_CAP) { atomicAdd(&bar[XB_TMO], 1u); break; } }
    }
    nloc = mine > 0u ? mine : 1u; nx = cnt > 0u ? cnt : 1u;
}
__device__ __forceinline__ void xcd_barrier(const XcdBarrier& b, const int tid_) {
    asm volatile("s_waitcnt vmcnt(0)" ::: "memory");
    __syncthreads();
    if (tid_ == 0) {
        unsigned* bar = b.bar;
        __builtin_amdgcn_s_waitcnt(0);
        unsigned nloc = b.st[0], nx = b.st[1];
        if (nloc == 0u) { xcd_barrier_complete(bar, b.x, nloc, nx); b.st[0] = nloc; b.st[1] = nx; }
        const unsigned old = xb_add(&bar[XB_XSUB(b.x)], 1u);
        const unsigned gen = old / nloc;
        if (old + 1u == (gen + 1u) * nloc) {
            __builtin_amdgcn_fence(__ATOMIC_RELEASE, "agent");
            asm volatile("s_waitcnt vmcnt(0)" ::: "memory");
            const unsigned og = xb_add(&bar[XB_TOP], 1u);
            const unsigned tg = og / nx;
            if (og + 1u == (tg + 1u) * nx) xb_add(&bar[XB_TOPGEN], 1u);
            else XB_SPIN(xb_ld(&bar[XB_TOPGEN]) == tg, bar);
            __builtin_amdgcn_fence(__ATOMIC_ACQUIRE, "agent");
            xb_add(&bar[XB_XGEN(b.x)], 1u);
            asm volatile("s_waitcnt vmcnt(0)" ::: "memory");
        } else {
            XB_SPIN(xb_ld(&bar[XB_XGEN(b.x)]) == gen, bar);
            __builtin_amdgcn_fence(__ATOMIC_ACQUIRE, "agent");
            asm volatile("s_waitcnt vmcnt(0)" ::: "memory");
        }
    }
    __syncthreads();
}

struct Params { const float* in[26]; float* out; unsigned char* ws; int ph_lo, ph_hi; };
enum { I_X = 0, I_C, I_CTX, I_CCTX, I_WADA, I_BADA, I_GATTN, I_GFFN, I_WIN, I_GQ, I_WUQ, I_GKV, I_WUKV, I_WFNET, I_BFNET, I_RPB, I_GOUT, I_WOUT,
       I_WRG, I_BRG, I_WRE, I_BRE, I_WGATE, I_WUP, I_WDOWN, I_GFINAL };

__device__ __forceinline__ const float* modp(const float* MOD, int l, int b, int which) { return MOD + ((size_t)(l * 5 + b) * 6 + which) * DM; }
__device__ __forceinline__ int row_batch(int r) { return r < T ? (r >> 11) : 4; }

template <bool BT, class AF, class BF, class EF>
__device__ __forceinline__ void sgemm_tile(float* lds, int m0, int n0, int M, int N, int K, const AF& af, const BF& bf, const EF& ef) {
    float* As = lds; float* Bs = lds + 16 * 132;
    const int tid = threadIdx.x, ty = tid >> 4, tx = tid & 15;
    float acc[4][8];
#pragma unroll
    for (int i = 0; i < 4; ++i)
#pragma unroll
        for (int j = 0; j < 8; ++j) acc[i][j] = 0.f;
    for (int k0 = 0; k0 < K; k0 += 16) {
#pragma unroll
        for (int i = 0; i < 4; ++i) { const int e = tid + i * 512, row = e >> 4, kk = e & 15; float v = 0.f; if (m0 + row < M) v = af(m0 + row, k0 + kk); As[kk * 132 + row] = v; }
#pragma unroll
        for (int i = 0; i < 4; ++i) { const int e = tid + i * 512; int kk, col; if (BT) { col = e >> 4; kk = e & 15; } else { kk = e >> 7; col = e & 127; }
            float v = 0.f; if (n0 + col < N) v = bf(k0 + kk, n0 + col); Bs[kk * 132 + col] = v; }
        __syncthreads();
#pragma unroll 2
        for (int kk = 0; kk < 16; ++kk) {
            const f32x4 a = *(const f32x4*)&As[kk * 132 + ty * 4];
            const f32x4 b0 = *(const f32x4*)&Bs[kk * 132 + tx * 8], b1 = *(const f32x4*)&Bs[kk * 132 + tx * 8 + 4];
#pragma unroll
            for (int i = 0; i < 4; ++i) {
#pragma unroll
                for (int j = 0; j < 4; ++j) { acc[i][j] = fmaf(a[i], b0[j], acc[i][j]); acc[i][4 + j] = fmaf(a[i], b1[j], acc[i][4 + j]); }
            }
        }
        __syncthreads();
    }
#pragma unroll
    for (int i = 0; i < 4; ++i) { const int row = m0 + ty * 4 + i; if (row < M && n0 + tx * 8 < N) ef(row, n0 + tx * 8, acc[i]); }
}
template <bool BT, class AF, class BF, class EF>
__device__ __forceinline__ void sgemm_phase(float* lds, int M, int N, int K, const AF& af, const BF& bf, const EF& ef) {
    const int tm = (M + 127) / 128, tn = (N + 127) / 128;
    for (int t = blockIdx.x; t < tm * tn; t += gridDim.x) sgemm_tile<BT>(lds, (t / tn) * 128, (t % tn) * 128, M, N, K, af, bf, ef);
}


namespace g8 {
typedef short bf16x8 __attribute__((ext_vector_type(8)));
constexpr int BM = 256, BK = 64, HALF = 128, HTB = HALF * BK * 2, STAGE_BYTES = 8 * HTB;
__device__ __forceinline__ int lds_byte(int r, int c) { const int st = (r >> 4) * 2 + (c >> 5), rr = r & 15, cc = c & 31, ob = rr * 64 + cc * 2; return st * 1024 + (ob ^ (((ob >> 9) & 1) << 5)); }
__device__ __forceinline__ void stage_rc(int b, int& R, int& C) { const int st = b / 1024, sb = b % 1024, swz = sb ^ (((sb >> 9) & 1) << 5); R = (st >> 1) * 16 + swz / 64; C = (st & 1) * 32 + (swz % 64) / 2; }
__device__ __forceinline__ int perm32(int rho) { const int n = rho >> 4, i = rho & 15; return 8 * (i >> 2) + 4 * n + (i & 3); }
__device__ __forceinline__ unsigned cvt_pk_bf16(float lo, float hi) { unsigned r; asm volatile("v_cvt_pk_bf16_f32 %0, %1, %2" : "=v"(r) : "v"(lo), "v"(hi)); return r; }

struct Unit { const char* A; const char* B; int pm, pn, aux, cnt; };

template <class Epi, class Sched>
__device__ __forceinline__ void gemm_phase(LAS unsigned char* lds, const int tid_in, const int K, const int lda, const int ldb, const Sched& S, const Epi& E) {
    int tid = tid_in; asm volatile("" : "+v"(tid));
    const int wid = __builtin_amdgcn_readfirstlane(tid >> 6), lane = tid & 63, wr = wid >> 2, wc = wid & 3, fr = lane & 15, fq = lane >> 4;
    const int nt = K / BK;
    int Rr[2], Cb[2]; unsigned voffB[2];
#pragma unroll
    for (int i = 0; i < 2; ++i) { int R, C; stage_rc(tid * 16 + i * 8192, R, C); const int Rb = Epi::PERM ? ((R & ~31) + perm32(R & 31)) : R; Rr[i] = R; Cb[i] = C * 2; voffB[i] = (unsigned)(Rb * ldb + C * 2); }
    const size_t kstep = (size_t)(BK * 2);
    const size_t hstepB = (size_t)HALF * ldb;
    const unsigned ldsw = (unsigned)wid * 1024u;
    const int aoff = lds_byte(wr * 64 + fr, fq * 8), boff = lds_byte(wc * 32 + fr, fq * 8);
#define G8_SA(b, h) (((b) * 2 + (h)) * HTB)
#define G8_SB(b, h) ((4 + (b) * 2 + (h)) * HTB)
#define G8_STAGE(bufoff, gbase, voff) do { _Pragma("unroll") for (int _i = 0; _i < 2; ++_i) \
        __builtin_amdgcn_global_load_lds((const unsigned*)((const char*)(gbase) + (voff)[_i]), (LAS unsigned*)(lds + (bufoff) + ldsw + _i * 8192), 16, 0, 0); } while (0)
#define G8_LDA(dst, b, h) do { _Pragma("unroll") for (int m = 0; m < 4; ++m) _Pragma("unroll") for (int k = 0; k < 2; ++k) dst[m][k] = *(const LAS bf16x8*)(lds + G8_SA(b, h) + aoff + m * 2048 + k * 1024); } while (0)
#define G8_LDB(dst, b, h) do { _Pragma("unroll") for (int n = 0; n < 2; ++n) _Pragma("unroll") for (int k = 0; k < 2; ++k) dst[n][k] = *(const LAS bf16x8*)(lds + G8_SB(b, h) + boff + n * 2048 + k * 1024); } while (0)
#define G8_MMA(ai, bj, At, Bt) do { __builtin_amdgcn_s_setprio(1); _Pragma("unroll") for (int m = 0; m < 4; ++m) _Pragma("unroll") for (int n = 0; n < 2; ++n) _Pragma("unroll") for (int k = 0; k < 2; ++k) \
        acc[ai][bj][m][n] = __builtin_amdgcn_mfma_f32_16x16x32_bf16(Bt[n][k], At[m][k], acc[ai][bj][m][n], 0, 0, 0); __builtin_amdgcn_s_setprio(0); } while (0)
#define G8_WAIT_V(n) asm volatile("s_waitcnt vmcnt(" #n ")" ::: "memory")
#define G8_WAIT_L(n) asm volatile("s_waitcnt lgkmcnt(" #n ")" ::: "memory")
#define G8_BAR __builtin_amdgcn_s_barrier()
#define G8_SCHED __builtin_amdgcn_sched_barrier(0)
    Unit cur, nxt; int ui = 0;
    if (!S.next(0, cur)) return;
    f32x4 acc[2][2][4][2];
#pragma unroll
    for (int a = 0; a < 2; ++a)
#pragma unroll
        for (int b = 0; b < 2; ++b)
#pragma unroll
            for (int m = 0; m < 4; ++m)
#pragma unroll
                for (int n = 0; n < 2; ++n) acc[a][b][m][n] = (f32x4){0.f, 0.f, 0.f, 0.f};
    bf16x8 At[4][2], B0[2][2], B1[2][2];
    constexpr int NG = Sched::GATHER ? 2 : 1;
    unsigned cva[NG][2], nva[NG][2];
    const size_t hstepA = Sched::GATHER ? 0 : (size_t)HALF * lda;
#pragma unroll
    for (int h = 0; h < NG; ++h)
#pragma unroll
        for (int i = 0; i < 2; ++i) cva[h][i] = S.arow(cur, h * HALF + Rr[i], lda) + (unsigned)Cb[i];
    const char* cA = cur.A; const char* cB = cur.B;
    G8_STAGE(G8_SB(0, 0), cB, voffB); G8_STAGE(G8_SB(0, 1), cB + hstepB, voffB); G8_STAGE(G8_SA(0, 0), cA, cva[0]); G8_STAGE(G8_SA(0, 1), cA + hstepA, cva[NG - 1]);
    if (wr == 1) G8_BAR;
    G8_WAIT_V(2); G8_BAR;
    G8_STAGE(G8_SB(1, 0), cB + kstep, voffB); G8_STAGE(G8_SA(1, 0), cA + kstep, cva[0]); G8_STAGE(G8_SB(1, 1), cB + hstepB + kstep, voffB);
    G8_WAIT_V(6); G8_BAR;
    for (;;) {
        const bool has_next = S.next(ui + 1, nxt);
        const char* nA = has_next ? nxt.A : cA; const char* nB = has_next ? nxt.B : cB;
        if (Sched::GATHER) {
#pragma unroll
            for (int h = 0; h < NG; ++h)
#pragma unroll
                for (int i = 0; i < 2; ++i) nva[h][i] = has_next ? S.arow(nxt, h * HALF + Rr[i], lda) + (unsigned)Cb[i] : cva[h][i];
        }
#pragma unroll 1
        for (int t = 0; t < nt; t += 2) {
            const bool last = (t == nt - 2);
            const char* a1 = cA + (size_t)(t + 1) * kstep;
            const char* a2 = last ? nA : cA + (size_t)(t + 2) * kstep; const char* b2 = last ? nB : cB + (size_t)(t + 2) * kstep;
            const char* a3 = a2 + kstep; const char* b3 = b2 + kstep;
            unsigned o2[NG][2];
#pragma unroll
            for (int h = 0; h < NG; ++h)
#pragma unroll
                for (int i = 0; i < 2; ++i) o2[h][i] = (Sched::GATHER && last) ? nva[h][i] : cva[h][i];
            G8_LDB(B0, 0, 0); G8_LDB(B1, 0, 1); G8_SCHED; G8_LDA(At, 0, 0); G8_STAGE(G8_SA(1, 1), a1 + hstepA, cva[NG - 1]);
            G8_WAIT_V(8); G8_WAIT_L(0); G8_BAR; G8_MMA(0, 0, At, B0); G8_MMA(0, 1, At, B1); G8_BAR; G8_SCHED;
            G8_LDA(At, 0, 1); G8_STAGE(G8_SB(0, 0), b2, voffB); G8_STAGE(G8_SB(0, 1), b2 + hstepB, voffB); G8_STAGE(G8_SA(0, 0), a2, o2[0]);
            G8_WAIT_V(8); G8_WAIT_L(0); G8_BAR; G8_MMA(1, 0, At, B0); G8_MMA(1, 1, At, B1); G8_BAR; G8_SCHED;
            G8_LDB(B0, 1, 0); G8_LDB(B1, 1, 1); G8_SCHED; G8_LDA(At, 1, 0); G8_STAGE(G8_SA(0, 1), a2 + hstepA, o2[NG - 1]);
            G8_WAIT_V(8); G8_WAIT_L(0); G8_BAR; G8_MMA(0, 0, At, B0); G8_MMA(0, 1, At, B1); G8_BAR; G8_SCHED;
            G8_LDA(At, 1, 1); G8_STAGE(G8_SB(1, 0), b3, voffB); G8_STAGE(G8_SB(1, 1), b3 + hstepB, voffB); G8_STAGE(G8_SA(1, 0), a3, o2[0]);
            G8_WAIT_V(8); G8_WAIT_L(0); G8_BAR; G8_MMA(1, 0, At, B0); G8_MMA(1, 1, At, B1); G8_BAR; G8_SCHED;
        }
        if (wr == 0) G8_BAR;
        E(acc, cur, wr, wc, fr, fq);
        if (!has_next) break;
#pragma unroll
        for (int a = 0; a < 2; ++a)
#pragma unroll
            for (int b = 0; b < 2; ++b)
#pragma unroll
                for (int m = 0; m < 4; ++m)
#pragma unroll
                    for (int n = 0; n < 2; ++n) acc[a][b][m][n] = (f32x4){0.f, 0.f, 0.f, 0.f};
        cur = nxt; cA = nA; cB = nB; ++ui;
        if (Sched::GATHER) {
#pragma unroll
            for (int h = 0; h < NG; ++h)
#pragma unroll
                for (int i = 0; i < 2; ++i) cva[h][i] = nva[h][i];
        }
        if (wr == 1) G8_BAR;
    }
    G8_WAIT_V(0);
    G8_BAR;
#undef G8_SA
#undef G8_SB
#undef G8_STAGE
#undef G8_LDA
#undef G8_LDB
#undef G8_MMA
#undef G8_WAIT_V
#undef G8_WAIT_L
#undef G8_BAR
#undef G8_SCHED
}

struct DenseSched {
    static constexpr bool GATHER = false;
    const char* A; const char* B; int nM, nN, G, c; size_t astep, bstep;
    __device__ __forceinline__ bool next(int i, Unit& u) const { const int L = i * G + c; if (L >= nM * nN) return false; u.pm = L / nN; u.pn = L % nN; u.aux = 0; u.cnt = 256;
        u.A = A + (size_t)u.pm * astep; u.B = B + (size_t)u.pn * bstep; return true; }
    __device__ __forceinline__ unsigned arow(const Unit&, int r, int lda) const { return (unsigned)(r * lda); }
};
}

__device__ __forceinline__ void tconv_item(const float* W, int ldw, int k0, int n0, bf16_t* dst_row0, int ldd, int rowstep, const float* kscale, LAS float* scr, int lane) {
#pragma unroll 8
    for (int i = 0; i < 32; ++i) { const int kk = 2 * i + (lane >> 5); float v = W[(size_t)(k0 + kk) * ldw + n0 + (lane & 31)]; if (kscale) v *= kscale[k0 + kk]; scr[kk * 33 + (lane & 31)] = v; }
    asm volatile("s_waitcnt lgkmcnt(0)" ::: "memory");
    const int c = lane & 7;
#pragma unroll
    for (int j = 0; j < 4; ++j) { const int n = (lane >> 3) + 8 * j; const LAS float* sp = scr + (8 * c) * 33 + n;
        u32x4 o; o.x = pk2(sp[0 * 33], sp[1 * 33]); o.y = pk2(sp[2 * 33], sp[3 * 33]); o.z = pk2(sp[4 * 33], sp[5 * 33]); o.w = pk2(sp[6 * 33], sp[7 * 33]);
        *(u32x4*)(dst_row0 + (size_t)n * rowstep + k0 + 8 * c) = o; }
    asm volatile("s_waitcnt lgkmcnt(0)" ::: "memory");
    (void)ldd;
}


#if OPT_L2
constexpr int SSQW = 12;
__device__ __forceinline__ float ssq_q(const float* SSQ, int row) { const f32x4 a = *(const f32x4*)(SSQ + row * 12), b = *(const f32x4*)(SSQ + row * 12 + 4); return ((a.x + a.y) + (a.z + a.w)) + ((b.x + b.y) + (b.z + b.w)); }
__device__ __forceinline__ float ssq_kv(const float* SSQ, int row) { const f32x4 a = *(const f32x4*)(SSQ + row * 12 + 8); return (a.x + a.y) + (a.z + a.w); }
#else
constexpr int SSQW = 96;
__device__ __forceinline__ float ssq_q(const float* SSQ, int row) { float sq = 0.f; for (int i = 0; i < 64; ++i) sq += SSQ[row * 96 + i]; return sq; }
__device__ __forceinline__ float ssq_kv(const float* SSQ, int row) { float sq = 0.f; for (int i = 64; i < 96; ++i) sq += SSQ[row * 96 + i]; return sq; }
#endif

struct EpiL2 {
    static constexpr bool PERM = true;
    bf16_t *ZQ, *ZKV, *KR, *ZF, *NAQ, *NAK, *NAV; float* SSQ; const float* ROPE;
    __device__ __forceinline__ void operator()(const f32x4 (&acc)[2][2][4][2], const g8::Unit& u, int wr, int wc, int fr, int fq) const {
#pragma unroll
        for (int ai = 0; ai < 2; ++ai)
#pragma unroll
            for (int m = 0; m < 4; ++m) {
                const int row = u.pm * 256 + ai * 128 + wr * 64 + m * 16 + fr; float ss = 0.f;
#pragma unroll
                for (int bj = 0; bj < 2; ++bj) {
                    const int c0 = u.pn * 256 + bj * 128 + wc * 32 + 8 * fq; f32x4 v0 = acc[ai][bj][m][0], v1 = acc[ai][bj][m][1]; bf16_t* dst;
                    if (c0 < C_ZKV) { dst = ZQ + (size_t)row * QL + c0; ss += (v0.x * v0.x + v0.y * v0.y) + (v0.z * v0.z + v0.w * v0.w) + (v1.x * v1.x + v1.y * v1.y) + (v1.z * v1.z + v1.w * v1.w); }
                    else if (c0 < C_ZKR) { dst = ZKV + (size_t)row * KVL + (c0 - C_ZKV); ss += (v0.x * v0.x + v0.y * v0.y) + (v0.z * v0.z + v0.w * v0.w) + (v1.x * v1.x + v1.y * v1.y) + (v1.z * v1.z + v1.w * v1.w); }
                    else if (c0 < C_ZF) { dst = KR + (size_t)row * KRD + (c0 - C_ZKR);
                        if (row < T) { const f32x4* rp = (const f32x4*)(ROPE + ((size_t)(row & (SEQ - 1)) * 32 + ((c0 - C_ZKR) >> 1)) * 2); const f32x4 r0 = rp[0], r1 = rp[1];
                            const f32x4 a = v0, b = v1;
                            v0.x = a.x * r0.x - a.y * r0.y; v0.y = a.x * r0.y + a.y * r0.x; v0.z = a.z * r0.z - a.w * r0.w; v0.w = a.z * r0.w + a.w * r0.z;
                            v1.x = b.x * r1.x - b.y * r1.y; v1.y = b.x * r1.y + b.y * r1.x; v1.z = b.z * r1.z - b.w * r1.w; v1.w = b.z * r1.w + b.w * r1.z; } }
                    else if (c0 < C_NAQ) dst = ZF + (size_t)row * FW + (c0 - C_ZF);
                    else if (c0 < C_NAK) dst = NAQ + (size_t)row * NAW + (c0 - C_NAQ);
                    else if (c0 < C_NAV) dst = NAK + (size_t)row * NAW + (c0 - C_NAK);
                    else if (c0 < INC) dst = NAV + (size_t)row * NAW + (c0 - C_NAV);
                    else dst = nullptr;
                    if (dst) { u32x4 w; w.x = g8::cvt_pk_bf16(v0.x, v0.y); w.y = g8::cvt_pk_bf16(v0.z, v0.w); w.z = g8::cvt_pk_bf16(v1.x, v1.y); w.w = g8::cvt_pk_bf16(v1.z, v1.w); *(u32x4*)dst = w; }
                }
                if (u.pn <= 2) { const int ln = fq * 16 + fr; ss += shx(ss, 16, ln); ss += shx(ss, 32, ln); if (fq == 0) SSQ[row * 12 + u.pn * 4 + wc] = ss; }
            }
    }
};

__device__ __forceinline__ u32x4 pack8(const f32x4& v0, const f32x4& v1) { u32x4 w; w.x = g8::cvt_pk_bf16(v0.x, v0.y); w.y = g8::cvt_pk_bf16(v0.z, v0.w); w.z = g8::cvt_pk_bf16(v1.x, v1.y); w.w = g8::cvt_pk_bf16(v1.z, v1.w); return w; }
struct EpiQ {
    static constexpr bool PERM = true;
    bf16_t* QB; const float* SSQ; const float* ROPE;
    __device__ __forceinline__ void operator()(const f32x4 (&acc)[2][2][4][2], const g8::Unit& u, int wr, int wc, int fr, int fq) const {
#pragma unroll
        for (int ai = 0; ai < 2; ++ai)
#pragma unroll
            for (int m = 0; m < 4; ++m) {
                const int row = u.pm * 256 + ai * 128 + wr * 64 + m * 16 + fr; const float rstd = rsqrtf(ssq_q(SSQ, row) * (1.0f / QL) + EPS);
#pragma unroll
                for (int bj = 0; bj < 2; ++bj) {
                    const int c0 = u.pn * 256 + bj * 128 + wc * 32 + 8 * fq, ch = c0 % DQK; f32x4 v0 = acc[ai][bj][m][0] * rstd, v1 = acc[ai][bj][m][1] * rstd;
                    if (row < T && ch >= DNOPE) { const f32x4* rp = (const f32x4*)(ROPE + ((size_t)(row & (SEQ - 1)) * 32 + ((ch - DNOPE) >> 1)) * 2); const f32x4 r0 = rp[0], r1 = rp[1]; const f32x4 a = v0, b = v1;
                        v0.x = a.x * r0.x - a.y * r0.y; v0.y = a.x * r0.y + a.y * r0.x; v0.z = a.z * r0.z - a.w * r0.w; v0.w = a.z * r0.w + a.w * r0.z;
                        v1.x = b.x * r1.x - b.y * r1.y; v1.y = b.x * r1.y + b.y * r1.x; v1.z = b.z * r1.z - b.w * r1.w; v1.w = b.z * r1.w + b.w * r1.z; }
                    *(u32x4*)(QB + (size_t)row * (NH * DQK) + c0) = pack8(v0, v1);
                }
            }
    }
};
struct EpiKV {
    static constexpr bool PERM = true;
    bf16_t *KN, *VB; const float* SSQ;
    __device__ __forceinline__ void operator()(const f32x4 (&acc)[2][2][4][2], const g8::Unit& u, int wr, int wc, int fr, int fq) const {
#pragma unroll
        for (int ai = 0; ai < 2; ++ai)
#pragma unroll
            for (int m = 0; m < 4; ++m) {
                const int row = u.pm * 256 + ai * 128 + wr * 64 + m * 16 + fr; const float rstd = rsqrtf(ssq_kv(SSQ, row) * (1.0f / KVL) + EPS);
                const size_t o = ((size_t)row * NH + u.pn) * 128 + wc * 32 + 8 * fq;
                *(u32x4*)(KN + o) = pack8(acc[ai][0][m][0] * rstd, acc[ai][0][m][1] * rstd);
                *(u32x4*)(VB + o) = pack8(acc[ai][1][m][0] * rstd, acc[ai][1][m][1] * rstd);
            }
    }
};
struct EpiF1 {
    static constexpr bool PERM = true;
    bf16_t *UVL, *UVC;
    __device__ __forceinline__ void operator()(const f32x4 (&acc)[2][2][4][2], const g8::Unit& u, int wr, int wc, int fr, int fq) const {
#pragma unroll
        for (int ai = 0; ai < 2; ++ai)
#pragma unroll
            for (int m = 0; m < 4; ++m) {
                const int j = u.pm * 256 + ai * 128 + wr * 64 + m * 16 + fr;
#pragma unroll
                for (int bj = 0; bj < 2; ++bj) {
                    const int n0 = u.pn * 256 + bj * 128 + wc * 32 + 8 * fq; bf16_t* dst;
                    if (n0 < T) { const int b = n0 >> 11, s_ = n0 & (SEQ - 1); dst = UVL + ((size_t)b * 512 + (j & 511)) * 4096 + (j >> 9) * SEQ + s_; }
                    else { const int n1 = n0 - T, b = n1 >> 8, s_ = n1 & 255; dst = UVC + ((size_t)b * 512 + (j & 511)) * 512 + (j >> 9) * CTXL + s_; }
                    *(u32x4*)dst = pack8(acc[ai][bj][m][0], acc[ai][bj][m][1]);
                }
            }
    }
};
struct EpiF2 {
    static constexpr bool PERM = false;
    float* OF; const float* bias; float scale; int rows_per_batch, row_base;
    __device__ __forceinline__ void operator()(const f32x4 (&acc)[2][2][4][2], const g8::Unit& u, int wr, int wc, int fr, int fq) const {
#pragma unroll
        for (int ai = 0; ai < 2; ++ai)
#pragma unroll
            for (int m = 0; m < 4; ++m) {
                const int row = row_base + u.aux * rows_per_batch + u.pm * 256 + ai * 128 + wr * 64 + m * 16 + fr;
#pragma unroll
                for (int bj = 0; bj < 2; ++bj)
#pragma unroll
                    for (int n = 0; n < 2; ++n) { const int col = u.pn * 256 + bj * 128 + wc * 32 + 16 * n + 4 * fq; const f32x4 bv = *(const f32x4*)(bias + col);
                        *(f32x4*)(OF + (size_t)row * FW + col) = acc[ai][bj][m][n] * scale + bv; }
            }
    }
};
struct F2Sched {
    static constexpr bool GATHER = false;
    const char* A; const char* B; int nM, G, c; size_t astep, bstep, bbatch;
    __device__ __forceinline__ bool next(int i, g8::Unit& u) const { const int L = i * G + c; if (L >= NB * nM * 2) return false; u.aux = L / (nM * 2); const int r = L % (nM * 2); u.pm = r >> 1; u.pn = r & 1; u.cnt = 256;
        u.A = A + (size_t)u.pm * astep; u.B = B + (size_t)u.aux * bbatch + (size_t)u.pn * bstep; return true; }
    __device__ __forceinline__ unsigned arow(const g8::Unit&, int r, int lda) const { return (unsigned)(r * lda); }
};
struct EpiOut {
    static constexpr bool PERM = false;
    float* XB; const float* x_in; const float* ctx_in; const float* MODl; int l;
    __device__ __forceinline__ void operator()(const f32x4 (&acc)[2][2][4][2], const g8::Unit& u, int wr, int wc, int fr, int fq) const {
#pragma unroll
        for (int ai = 0; ai < 2; ++ai)
#pragma unroll
            for (int m = 0; m < 4; ++m) {
                const int row = u.pm * 256 + ai * 128 + wr * 64 + m * 16 + fr; const int b = row_batch(row);
                const float* xr = (l == 0) ? (row < T ? x_in + (size_t)row * DM : ctx_in + (size_t)(row - T) * DM) : XB + (size_t)row * DM;
                const float* ga = MODl + ((size_t)b * 6 + 2) * DM;
#pragma unroll
                for (int bj = 0; bj < 2; ++bj)
#pragma unroll
                    for (int n = 0; n < 2; ++n) { const int col = u.pn * 256 + bj * 128 + wc * 32 + 16 * n + 4 * fq;
                        *(f32x4*)(XB + (size_t)row * DM + col) = *(const f32x4*)(xr + col) + *(const f32x4*)(ga + col) * acc[ai][bj][m][n]; }
            }
    }
};
constexpr int LDS_TAB = 131072 + 256;
struct MoeSched1 {
    static constexpr bool GATHER = true;
    const char* A; const char* B; const int* list; const LAS int* tp; const LAS int* cn; int G, c;
    __device__ __forceinline__ bool next(int i, g8::Unit& u) const { const int L = i * G + c; if (L >= tp[32] * 4) return false; const int mt = L >> 2; u.pn = L & 3; int e = 0;
        for (int q = 1; q < 32; ++q) e += (tp[q] <= mt) ? 1 : 0;
        u.aux = e; u.pm = mt - tp[e]; u.cnt = min(256, cn[e] - u.pm * 256) | (mt << 16); u.A = A; u.B = B + ((size_t)e * 1024 + u.pn * 256) * 4096; return true; }
    __device__ __forceinline__ unsigned arow(const g8::Unit& u, int r, int lda) const { const int i = min(u.pm * 256 + r, cn[u.aux] - 1); return (unsigned)list[(size_t)u.aux * MT + i] * (unsigned)lda; }
};
struct EpiGU {
    static constexpr bool PERM = true;
    bf16_t* HB; const float* lw;
    __device__ __forceinline__ void operator()(const f32x4 (&acc)[2][2][4][2], const g8::Unit& u, int wr, int wc, int fr, int fq) const {
        const int cntu = u.cnt & 0xffff, mt = u.cnt >> 16;
#pragma unroll
        for (int ai = 0; ai < 2; ++ai)
#pragma unroll
            for (int m = 0; m < 4; ++m) {
                const int r = ai * 128 + wr * 64 + m * 16 + fr;
                if (r < cntu) { const float w = lw[(size_t)u.aux * MT + u.pm * 256 + r];
                    const f32x4 g0 = acc[ai][0][m][0], g1 = acc[ai][0][m][1], u0 = acc[ai][1][m][0], u1 = acc[ai][1][m][1]; f32x4 h0, h1;
#pragma unroll
                    for (int e = 0; e < 4; ++e) { h0[e] = g0[e] / (1.0f + __expf(-g0[e])) * u0[e] * w; h1[e] = g1[e] / (1.0f + __expf(-g1[e])) * u1[e] * w; }
                    *(u32x4*)(HB + (size_t)(mt * 256 + r) * DE + u.pn * 128 + wc * 32 + 8 * fq) = pack8(h0, h1); }
            }
    }
};
struct MoeSched2 {
    static constexpr bool GATHER = false;
    const char* A; const char* B; const LAS int* tp; const LAS int* cn; int G, c;
    __device__ __forceinline__ bool next(int i, g8::Unit& u) const { const int L = i * G + c; if (L >= tp[32] * 8) return false; const int mt = L >> 3; u.pn = L & 7; int e = 0;
        for (int q = 1; q < 32; ++q) e += (tp[q] <= mt) ? 1 : 0;
        u.aux = e; u.pm = mt; u.cnt = min(256, cn[e] - (mt - tp[e]) * 256); u.A = A + (size_t)mt * 256 * 1024; u.B = B + ((size_t)e * 2048 + u.pn * 256) * 1024; return true; }
    __device__ __forceinline__ unsigned arow(const g8::Unit&, int r, int lda) const { return (unsigned)(r * lda); }
};
struct EpiDN {
    static constexpr bool PERM = true;
    bf16_t* YE;
    __device__ __forceinline__ void operator()(const f32x4 (&acc)[2][2][4][2], const g8::Unit& u, int wr, int wc, int fr, int fq) const {
#pragma unroll
        for (int ai = 0; ai < 2; ++ai)
#pragma unroll
            for (int m = 0; m < 4; ++m) {
                const int r = ai * 128 + wr * 64 + m * 16 + fr;
                if (r < u.cnt) {
#pragma unroll
                    for (int bj = 0; bj < 2; ++bj) *(u32x4*)(YE + (size_t)(u.pm * 256 + r) * DM + u.pn * 256 + bj * 128 + wc * 32 + 8 * fq) = pack8(acc[ai][bj][m][0], acc[ai][bj][m][1]); }
            }
    }
};

namespace at {
typedef short bf16x8 __attribute__((ext_vector_type(8)));
typedef short s16x4 __attribute__((ext_vector_type(4)));
typedef float f32x16 __attribute__((ext_vector_type(16)));
#define AT_SBAR() __builtin_amdgcn_sched_barrier(0)
__device__ __forceinline__ int crow(int r, int hi) { return (r & 3) + 8 * (r >> 2) + 4 * hi; }
__device__ __forceinline__ unsigned cvtpk(float lo, float hi) { unsigned r; asm volatile("v_cvt_pk_bf16_f32 %0, %1, %2" : "=v"(r) : "v"(lo), "v"(hi)); return r; }
template <int DKB> __device__ __forceinline__ int koff(int row, int cb) {
    if (DKB == 256) return row * 256 + (cb ^ ((row & 15) << 4));
    else return row * 384 + (cb ^ (((row >> 1) & 7) << 4));
}
__device__ __forceinline__ void partialSM(f32x16& p0, f32x16& p1, float& m_reg, float& mn, float& alpha, const float C, const float THRS) {
    float pmax = p0[0];
#pragma unroll
    for (int r = 1; r < 16; ++r) pmax = fmaxf(pmax, p0[r]);
#pragma unroll
    for (int r = 0; r < 16; ++r) pmax = fmaxf(pmax, p1[r]);
    { auto rr = __builtin_amdgcn_permlane32_swap(__float_as_uint(pmax), __float_as_uint(pmax), false, false); pmax = fmaxf(__uint_as_float(rr[0]), __uint_as_float(rr[1])); }
    if (__builtin_expect(__all(pmax - m_reg <= THRS), 1)) { mn = m_reg; alpha = 1.f; }
    else { mn = fmaxf(m_reg, pmax); alpha = __builtin_amdgcn_exp2f((m_reg - mn) * C); m_reg = mn; }
    const float mnC = -mn * C;
#pragma unroll
    for (int r = 0; r < 16; ++r) p0[r] = fmaf(p0[r], C, mnC);
#pragma unroll
    for (int r = 0; r < 16; ++r) p1[r] = fmaf(p1[r], C, mnC);
#pragma unroll
    for (int r = 0; r < 16; ++r) p0[r] = __builtin_amdgcn_exp2f(p0[r]);
}
__device__ __forceinline__ void finishSM(f32x16& p0, f32x16& p1, float alpha, float& l_reg, bf16x8& pa0, bf16x8& pa1, bf16x8& pa2, bf16x8& pa3) {
#pragma unroll
    for (int r = 0; r < 16; ++r) p1[r] = __builtin_amdgcn_exp2f(p1[r]);
    float ps = 0;
#pragma unroll
    for (int r = 0; r < 16; ++r) ps += p0[r];
#pragma unroll
    for (int r = 0; r < 16; ++r) ps += p1[r];
    { auto rr = __builtin_amdgcn_permlane32_swap(__float_as_uint(ps), __float_as_uint(ps), false, false); ps = __uint_as_float(rr[0]) + __uint_as_float(rr[1]); }
    l_reg = l_reg * alpha + ps;
#define AT_PK4(P, BASE, OUT) do { unsigned a0 = cvtpk(P[BASE + 0], P[BASE + 1]), a1 = cvtpk(P[BASE + 2], P[BASE + 3]);   \
    unsigned b0 = cvtpk(P[BASE + 4], P[BASE + 5]), b1 = cvtpk(P[BASE + 6], P[BASE + 7]);                              \
    auto r0 = __builtin_amdgcn_permlane32_swap(a0, b0, false, false); auto r1 = __builtin_amdgcn_permlane32_swap(a1, b1, false, false); \
    u32x4 w = {r0[0], r1[0], r0[1], r1[1]}; OUT = *reinterpret_cast<bf16x8*>(&w); } while (0)
    AT_PK4(p0, 0, pa0); AT_PK4(p0, 8, pa1); AT_PK4(p1, 0, pa2); AT_PK4(p1, 8, pa3);
#undef AT_PK4
}
template <int ND0, int DKB>
__device__ __forceinline__ void qkt(f32x16& p0, f32x16& p1, const char* Ks, const bf16x8 (&qr)[ND0], int r32, int hi) {
    p0 = f32x16{}; p1 = f32x16{};
#pragma unroll
    for (int d0 = 0; d0 < ND0; ++d0) { const int cb = (d0 * 16 + hi * 8) * 2;
        const bf16x8 b0 = *reinterpret_cast<const bf16x8*>(Ks + koff<DKB>(r32, cb));
        const bf16x8 b1 = *reinterpret_cast<const bf16x8*>(Ks + koff<DKB>(32 + r32, cb));
        p0 = __builtin_amdgcn_mfma_f32_32x32x16_bf16(b0, qr[d0], p0, 0, 0, 0);
        p1 = __builtin_amdgcn_mfma_f32_32x32x16_bf16(b1, qr[d0], p1, 0, 0, 0); }
}
__device__ __forceinline__ int v_st(int k, int c) { const int kk = (k & ~0xC) | ((k & 4) << 1) | ((k & 8) >> 1); return ((kk >> 3) * 4 + (c >> 5)) * 512 + ((kk & 7) * 32 + (c & 31)) * 2; }
__device__ __forceinline__ int v_rd_base(int lane) { return ((lane & 3) << 3) | (((lane >> 2) & 3) << 6) | (((lane >> 4) & 1) << 5) | (((lane >> 5) & 1) << 8); }
constexpr int v_rd_off(int d0, int ks, int half) { return d0 * 512 + ks * 4096 + half * 2048; }
template <int OFF> __device__ __forceinline__ s16x4 tr_read(int vb) { s16x4 r; asm volatile("ds_read_b64_tr_b16 %0, %1 offset:%2" : "=&v"(r) : "v"(vb), "i"(OFF) : "memory"); return r; }
template <int D0> __device__ __forceinline__ void pv_one(f32x16& od, int vb, bf16x8 pa0, bf16x8 pa1, bf16x8 pa2, bf16x8 pa3) {
    const s16x4 l0 = tr_read<v_rd_off(D0, 0, 0)>(vb), h0 = tr_read<v_rd_off(D0, 0, 1)>(vb), l1 = tr_read<v_rd_off(D0, 1, 0)>(vb), h1 = tr_read<v_rd_off(D0, 1, 1)>(vb);
    const s16x4 l2 = tr_read<v_rd_off(D0, 2, 0)>(vb), h2 = tr_read<v_rd_off(D0, 2, 1)>(vb), l3 = tr_read<v_rd_off(D0, 3, 0)>(vb), h3 = tr_read<v_rd_off(D0, 3, 1)>(vb);
    asm volatile("s_waitcnt lgkmcnt(0)" ::: "memory"); AT_SBAR();
#define AT_PK(L, H) (bf16x8){L[0], L[1], L[2], L[3], H[0], H[1], H[2], H[3]}
    od = __builtin_amdgcn_mfma_f32_32x32x16_bf16(pa0, AT_PK(l0, h0), od, 0, 0, 0);
    od = __builtin_amdgcn_mfma_f32_32x32x16_bf16(pa1, AT_PK(l1, h1), od, 0, 0, 0);
    od = __builtin_amdgcn_mfma_f32_32x32x16_bf16(pa2, AT_PK(l2, h2), od, 0, 0, 0);
    od = __builtin_amdgcn_mfma_f32_32x32x16_bf16(pa3, AT_PK(l3, h3), od, 0, 0, 0);
#undef AT_PK
}
__device__ __forceinline__ void pv_d0(f32x16* o, int vb, bf16x8 pa0, bf16x8 pa1, bf16x8 pa2, bf16x8 pa3) {
    pv_one<0>(o[0], vb, pa0, pa1, pa2, pa3); pv_one<1>(o[1], vb, pa0, pa1, pa2, pa3); pv_one<2>(o[2], vb, pa0, pa1, pa2, pa3); pv_one<3>(o[3], vb, pa0, pa1, pa2, pa3);
}
struct KeySrc { const bf16_t* kn; const bf16_t* kr; const bf16_t* v; int ldk, ldv, ctx0, lat0, nctx; };
constexpr int LDS_ATT_V = 0, LDS_ATT_K = 32768, LDS_ATT_W = 32768 + 2 * 24576, LDS_ATT_END = LDS_ATT_W + 2048;
template <int ND0, class Hook>
__device__ __forceinline__ void attn_unit(const bf16_t* __restrict__ Qb, const int ldq, const KeySrc ks, const int NT, const Hook& hook, const float C, const float THRS,
                                          bf16_t* __restrict__ Ob, const int ldo, char* lds, const int tid_in) {
    constexpr int DKB = ND0 * 32, SHM_V = 16384, SHM_K = 64 * DKB;
    int tid = tid_in; asm volatile("" : "+v"(tid));
    const int wid = tid >> 6, lane = tid & 63, r32 = lane & 31, hi = lane >> 5;
    char* V_lds = lds + LDS_ATT_V; char* K_lds = lds + LDS_ATT_K;
    float* wsf = (float*)(lds + LDS_ATT_W) + wid * 64; float* li_l = wsf; float* al_l = wsf + 32;
    float m_reg = -1e30f, l_reg = 0; f32x16 o[4] = {}; bf16x8 qr[ND0];
    const bf16_t* Qw = Qb + (long)(wid * 32 + r32) * ldq + hi * 8;
#pragma unroll
    for (int d0 = 0; d0 < ND0; ++d0) qr[d0] = *reinterpret_cast<const bf16x8*>(Qw + d0 * 16);
    const int sr = tid >> 4, sc = (tid & 15) * 8, vst0 = v_st(sr, sc), vst1 = v_st(32 + sr, sc);
    const int rr_ = tid >> 3, rc_ = (tid & 7) * 8;
    const int vb0 = (int)(uintptr_t)V_lds + v_rd_base(lane);
    bf16x8 vs0, vs1, ks0, ks1, kr0;
#define AT_KROW(t) ((t) < ks.nctx ? ks.ctx0 + (t) * 64 : ks.lat0 + ((t) - ks.nctx) * 64)
#define AT_SLOAD(t) do { const long k0_ = AT_KROW(t); vs0 = *reinterpret_cast<const bf16x8*>(ks.v + (k0_ + sr) * ks.ldv + sc); vs1 = *reinterpret_cast<const bf16x8*>(ks.v + (k0_ + 32 + sr) * ks.ldv + sc); \
    ks0 = *reinterpret_cast<const bf16x8*>(ks.kn + (k0_ + sr) * ks.ldk + sc); ks1 = *reinterpret_cast<const bf16x8*>(ks.kn + (k0_ + 32 + sr) * ks.ldk + sc); \
    if (ND0 == 12) kr0 = *reinterpret_cast<const bf16x8*>(ks.kr + (k0_ + rr_) * 64 + rc_); } while (0)
#define AT_SWRITE(b) do { *(bf16x8*)(V_lds + (b) * SHM_V + vst0) = vs0; *(bf16x8*)(V_lds + (b) * SHM_V + vst1) = vs1; \
    *(bf16x8*)(K_lds + (b) * SHM_K + koff<DKB>(sr, sc * 2)) = ks0; *(bf16x8*)(K_lds + (b) * SHM_K + koff<DKB>(32 + sr, sc * 2)) = ks1; \
    if (ND0 == 12) *(bf16x8*)(K_lds + (b) * SHM_K + koff<DKB>(rr_, 256 + rc_ * 2)) = kr0; } while (0)
#define AT_RESC(a) do { if (__any((a) < 1.f)) { if (hi == 0) al_l[r32] = (a); asm volatile("s_waitcnt lgkmcnt(0)" ::: "memory"); \
    _Pragma("unroll") for (int d = 0; d < 4; ++d) _Pragma("unroll") for (int r = 0; r < 16; ++r) o[d][r] *= al_l[crow(r, hi)]; } } while (0)
    f32x16 p0, p1; float mn, al; bf16x8 pa0, pa1, pa2, pa3;
    AT_SLOAD(0); asm volatile("s_waitcnt vmcnt(0)" ::: "memory"); AT_SWRITE(0); __syncthreads();
    AT_SLOAD(1);
    for (int j = 0; j < NT; ++j) {
        const int bsel = j & 1;
        AT_SBAR(); qkt<ND0, DKB>(p0, p1, K_lds + bsel * SHM_K, qr, r32, hi); hook(p0, p1, j);
        partialSM(p0, p1, m_reg, mn, al, C, THRS);
        AT_RESC(al);
        finishSM(p0, p1, al, l_reg, pa0, pa1, pa2, pa3); AT_SBAR();
        if (j + 1 < NT) { asm volatile("s_waitcnt vmcnt(0)" ::: "memory"); if (bsel) { AT_SWRITE(0); } else { AT_SWRITE(1); } }
        if (j + 2 < NT) { AT_SLOAD(j + 2); }
        AT_SBAR();
        pv_d0(o, vb0 + bsel * SHM_V, pa0, pa1, pa2, pa3);
        __syncthreads();
    }
    if (hi == 0) li_l[r32] = l_reg; asm volatile("s_waitcnt lgkmcnt(0)" ::: "memory");
    float rli[16];
#pragma unroll
    for (int r = 0; r < 16; ++r) rli[r] = __builtin_amdgcn_rcpf(li_l[crow(r, hi)]);
    bf16_t* Ow = Ob + (long)(wid * 32) * ldo;
#pragma unroll
    for (int r = 0; r < 16; ++r) { const int orow = crow(r, hi);
#pragma unroll
        for (int d0 = 0; d0 < 4; ++d0) Ow[(long)orow * ldo + d0 * 32 + r32] = f2bf(o[d0][r] * rli[r]); }
#undef AT_KROW
#undef AT_SLOAD
#undef AT_SWRITE
#undef AT_RESC
}
struct NoHook { __device__ __forceinline__ void operator()(f32x16&, f32x16&, int) const {} };
struct NaHook {
    const float* tab; int lo, r, rs, cq, cs, hi4;
    __device__ __forceinline__ void operator()(f32x16& p0, f32x16& p1, int t) const {
        if (t < 4) return;
        const int kr = lo + (t - 4);
        if (kr < rs || kr >= rs + 8) {
#pragma unroll
            for (int i = 0; i < 16; ++i) { p0[i] = -1.0e30f; p1[i] = -1.0e30f; }
            return; }
        const float* trow = tab + (kr - r + 7) * 32 + (15 - cq);
#pragma unroll
        for (int i = 0; i < 16; ++i) { const int ck = (i & 3) + 8 * (i >> 2) + hi4;
            p0[i] = ((unsigned)(ck - cs) < 16u) ? p0[i] + trow[ck] : -1.0e30f;
            p1[i] = ((unsigned)(ck + 32 - cs) < 16u) ? p1[i] + trow[ck + 32] : -1.0e30f; }
    }
};
}

template <int DK1, int DK2, class CF, class BiasF>
__device__ __forceinline__ void naive_attn_row(const bf16_t* q, float scale, int nkeys, const CF& chunk, const BiasF& bias, bf16_t* out, float* qs, int lane) {
    for (int d = lane; d < DK1 + DK2; d += 64) qs[d] = bf2f(q[d]);
    __builtin_amdgcn_wave_barrier();
    asm volatile("s_waitcnt lgkmcnt(0)" ::: "memory");
    float m = -3.0e38f, l = 0.f, o0 = 0.f, o1 = 0.f;
    for (int kt = 0; kt < nkeys; kt += 64) {
        const bf16_t *kn, *kr, *v; int kns, krs, vs;
        chunk(kt, kn, kns, kr, krs, v, vs);
        const bf16_t* k1 = kn + (size_t)lane * kns;
        float s = 0.f;
#pragma unroll 4
        for (int d = 0; d < DK1; d += 8) { const u32x4 w = *(const u32x4*)(k1 + d);
            s += qs[d] * __uint_as_float(w.x << 16) + qs[d + 1] * __uint_as_float(w.x & 0xffff0000u) + qs[d + 2] * __uint_as_float(w.y << 16) + qs[d + 3] * __uint_as_float(w.y & 0xffff0000u)
               + qs[d + 4] * __uint_as_float(w.z << 16) + qs[d + 5] * __uint_as_float(w.z & 0xffff0000u) + qs[d + 6] * __uint_as_float(w.w << 16) + qs[d + 7] * __uint_as_float(w.w & 0xffff0000u); }
        if (DK2 > 0) { const bf16_t* k2 = kr + (size_t)lane * krs;
#pragma unroll 4
            for (int d = 0; d < DK2; d += 8) { const u32x4 w = *(const u32x4*)(k2 + d); const float* qq = qs + DK1 + d;
                s += qq[0] * __uint_as_float(w.x << 16) + qq[1] * __uint_as_float(w.x & 0xffff0000u) + qq[2] * __uint_as_float(w.y << 16) + qq[3] * __uint_as_float(w.y & 0xffff0000u)
                   + qq[4] * __uint_as_float(w.z << 16) + qq[5] * __uint_as_float(w.z & 0xffff0000u) + qq[6] * __uint_as_float(w.w << 16) + qq[7] * __uint_as_float(w.w & 0xffff0000u); } }
        s = s * scale + bias(kt + lane);
        const float mn = fmaxf(m, wave_max(s));
        const float pj = __expf(s - mn), alpha = __expf(m - mn);
        l = l * alpha + wave_sum(pj); o0 *= alpha; o1 *= alpha; m = mn;
        for (int j = 0; j < 64; ++j) { const float pv = __int_as_float(__builtin_amdgcn_readlane(__float_as_int(pj), j)); const bf16_t* vr = v + (size_t)j * vs; o0 = fmaf(pv, bf2f(vr[lane]), o0); o1 = fmaf(pv, bf2f(vr[lane + 64]), o1); }
    }
    const float rl = 1.0f / l;
    out[lane] = f2bf(o0 * rl); out[lane + 64] = f2bf(o1 * rl);
}

#define DEFPTRS const __attribute__((address_space(4))) Params* kp_ = (const __attribute__((address_space(4))) Params*)__builtin_amdgcn_kernarg_segment_ptr(); asm volatile("" : "+s"(kp_)); \
    const __attribute__((address_space(4))) Params& p = *kp_; unsigned char* ws = p.ws; unsigned* ctl = (unsigned*)ws; (void)ctl; \
    int wave = wave_s; asm volatile("" : "+s"(wave)); int lane; asm volatile("v_mbcnt_lo_u32_b32 %0, -1, 0\n\tv_mbcnt_hi_u32_b32 %0, -1, %0" : "=v"(lane)); const int tid = wave * 64 + lane, gw = blockIdx.x * 8 + wave, NGW = gridDim.x * 8; (void)lane; (void)gw; (void)NGW; \
    float* ldsf = (float*)lds_raw; (void)ldsf; \
    float* MOD = (float*)(ws + CB_MOD); \
    float* ROPE = (float*)(ws + O_ROPE); float* COSL = (float*)(ws + O_COSL); float* WF = (float*)(ws + O_WF); float* SSQ = (float*)(ws + O_SSQ); \
    int* RTE = (int*)(ws + O_RTE); int* LIST = (int*)(ws + O_LIST); float* LW = (float*)(ws + O_LW); \
    bf16_t* H = (bf16_t*)(ws + O_H); float* XB = (float*)(ws + O_XB); bf16_t* HB = (bf16_t*)(ws + O_HB); \
    bf16_t* ZQ = (bf16_t*)(ws + O_ZQ); bf16_t* ZKV = (bf16_t*)(ws + O_ZKV); bf16_t* KR = (bf16_t*)(ws + O_KR); bf16_t* ZF = (bf16_t*)(ws + O_ZF); \
    bf16_t* NAQ = (bf16_t*)(ws + O_NAQ); bf16_t* NAK = (bf16_t*)(ws + O_NAK); bf16_t* NAV = (bf16_t*)(ws + O_NAV); \
    bf16_t* QB = (bf16_t*)(ws + O_QB); bf16_t* KN = (bf16_t*)(ws + O_KN); bf16_t* VB = (bf16_t*)(ws + O_VB); \
    bf16_t* UVL = (bf16_t*)(ws + O_UVL); bf16_t* UVC = (bf16_t*)(ws + O_UVC); \
    bf16_t* OM = (bf16_t*)(ws + O_OM); float* OF = (float*)(ws + O_OF); bf16_t* ON = (bf16_t*)(ws + O_ON); bf16_t* Y = (bf16_t*)(ws + O_Y); bf16_t* YE = (bf16_t*)(ws + O_YE);
__global__ void __launch_bounds__(512, 2) fwd_kernel(Params p) {
    extern __shared__ __attribute__((aligned(16))) unsigned char lds_raw[];
    volatile LAS unsigned* misc = (volatile LAS unsigned*)((LAS unsigned char*)lds_raw + LDS_MISC);
    const int wave_s = __builtin_amdgcn_readfirstlane((int)(threadIdx.x >> 6));
    if (threadIdx.x < 64) misc[threadIdx.x] = 0u;
    __syncthreads();
    XcdBarrier bar; bar.bar = (unsigned*)p.ws + CW_BAR; bar.x = 0; bar.st = misc;
    if (p.ph_hi - p.ph_lo > 1) bar = xcd_barrier_post((unsigned*)p.ws + CW_BAR, misc);

    int ph = 0;
#define PHASE_BEGIN if (ph >= p.ph_lo && ph < p.ph_hi) { DEFPTRS
#define LAYERPTRS const float* g_attn = p.in[I_GATTN] + l * DM; const float* g_ffn = p.in[I_GFFN] + l * DM; (void)g_attn; (void)g_ffn; \
    int* cnt = (int*)(ctl + CW_CNT) + l * 32 * 64; int* rte = RTE + (size_t)l * MT * 4; int* list = LIST + (size_t)l * 32 * MT; float* lw = LW + (size_t)l * 32 * MT; (void)cnt; (void)rte; (void)list; (void)lw;
#define PHASE_END   if (ph + 1 < p.ph_hi) { int l2_; asm volatile("v_mbcnt_lo_u32_b32 %0, -1, 0\n\tv_mbcnt_hi_u32_b32 %0, -1, %0" : "=v"(l2_)); xcd_barrier(bar, wave_s * 64 + l2_); } } ++ph;

    PHASE_BEGIN
    {
        float* sl = ldsf;
        for (int task = blockIdx.x; task < 2 * 16 * 24; task += gridDim.x) {
            const int l = task / (16 * 24), r = task % (16 * 24), ks = r / 24, nb = r % 24, k0 = ks * 128, n = nb * 512 + tid;
            __syncthreads();
            for (int i = tid; i < 5 * 128; i += 512) { const int rr = i / 128, kk = i % 128; const float cv = rr < 4 ? p.in[I_C][rr * DM + k0 + kk] : p.in[I_CCTX][k0 + kk]; sl[i] = silu(cv); }
            __syncthreads();
            float a0 = 0.f, a1 = 0.f, a2 = 0.f, a3 = 0.f, a4 = 0.f;
            const float* w = p.in[I_WADA] + ((size_t)l * DM + k0) * (6 * DM) + n;
            for (int kk = 0; kk < 128; ++kk) { const float wv = w[(size_t)kk * (6 * DM)]; a0 = fmaf(sl[kk], wv, a0); a1 = fmaf(sl[128 + kk], wv, a1); a2 = fmaf(sl[256 + kk], wv, a2); a3 = fmaf(sl[384 + kk], wv, a3); a4 = fmaf(sl[512 + kk], wv, a4); }
            if (ks == 0) { const float bv = p.in[I_BADA][l * 6 * DM + n]; a0 += bv; a1 += bv; a2 += bv; a3 += bv; a4 += bv; }
            float* mo = XB + (size_t)ks * (2 * 5 * 6 * DM) + (size_t)(l * 5) * (6 * DM) + n;
            mo[0] = a0; mo[6 * DM] = a1; mo[12 * DM] = a2; mo[18 * DM] = a3; mo[24 * DM] = a4;
        }
        const int gt = blockIdx.x * 512 + tid, NT_ = gridDim.x * 512;
        for (int i = gt; i < SEQ * 32; i += NT_) { const int s = i >> 5, j = i & 31; const float invf = powf(10000.0f, -(float)(2 * (j & 15)) / 32.0f);
            const float pos = (float)(j < 16 ? (s >> 6) : (s & 63)); const float ang = pos * invf; ROPE[2 * i] = cosf(ang); ROPE[2 * i + 1] = sinf(ang); }
        for (int i = gt; i < SEQ; i += NT_) COSL[i] = cospif((float)i * (2.0f / (float)SEQ));
        for (int i = gt; i < 2 * 1024 * 512; i += NT_) { const int l = i >> 19, r = i & ((1 << 19) - 1), k = r >> 10, j = r & 1023, g = k >> 7, c = k & 127, jj = j & 511;
            const float* wf = p.in[I_WFNET] + ((size_t)l * FW + g * 128) * FW + jj; float a = 0.f;
            for (int m = 0; m < 128; ++m) { const int ph_ = (m * c) & 127; const float tv = (j < 512) ? cospif((float)ph_ * (1.0f / 64.0f)) : sinpif((float)ph_ * (1.0f / 64.0f)); a = fmaf(tv, wf[(size_t)m * FW], a); }
            WF[((size_t)l * 1024 + j) * 512 + k] = a; ((bf16_t*)(ws + O_WFA))[((size_t)l * 1024 + j) * 512 + k] = f2bf(a); }
        for (int i = gt; i < SEQ * 4096 / 8; i += NT_) { const int k = i >> 9, kk0 = (i & 511) * 8; unsigned w[4];
#pragma unroll
            for (int q = 0; q < 4; ++q) { float v[2];
#pragma unroll
                for (int e = 0; e < 2; ++e) { const int kk = kk0 + 2 * q + e, n = kk & (SEQ - 1); const float ang = (float)((k * n) & (SEQ - 1)) * (1.0f / 1024.0f); v[e] = kk < SEQ ? cospif(ang) : -sinpif(ang); }
                w[q] = pk2(v[0], v[1]); }
            *(u32x4*)((bf16_t*)(ws + O_DFTL) + (size_t)k * 4096 + kk0) = (u32x4){w[0], w[1], w[2], w[3]}; }
        for (int i = gt; i < CTXL * 512 / 8; i += NT_) { const int k = i >> 6, kk0 = (i & 63) * 8; unsigned w[4];
#pragma unroll
            for (int q = 0; q < 4; ++q) { float v[2];
#pragma unroll
                for (int e = 0; e < 2; ++e) { const int kk = kk0 + 2 * q + e, n = kk & (CTXL - 1); const float ang = (float)((k * n) & (CTXL - 1)) * (1.0f / 128.0f); v[e] = kk < CTXL ? cospif(ang) : -sinpif(ang); }
                w[q] = pk2(v[0], v[1]); }
            *(u32x4*)((bf16_t*)(ws + O_DFTC) + (size_t)k * 512 + kk0) = (u32x4){w[0], w[1], w[2], w[3]}; }
        for (int i = gt; i < 2 * 192 * 2048 / 8; i += NT_) { const int l = i / (192 * 256), r = i % (192 * 256); *(u32x4*)((bf16_t*)(ws + O_WIN) + ((size_t)l * 3072 + 2880) * 2048 + (size_t)r * 8) = (u32x4){0u, 0u, 0u, 0u}; }
        {
            LAS float* scr = (LAS float*)((LAS unsigned char*)lds_raw + 16384 + wave * 8704);
            constexpr int N_IN = 32 * 90, N_UQ = 8 * 48, N_UKV = 4 * 64, N_OUT = 32 * 64, N_G = 32 * 32 * 16, N_D = 32 * 8 * 64, N_L = N_IN + N_UQ + N_UKV + N_OUT + 2 * N_G + N_D;
            for (int it = gw; it < 2 * N_L; it += NGW) {
                const int l = it / N_L; int r = it % N_L;
                if (r < N_IN) { const int kb = r / 90, nb = r % 90; tconv_item(p.in[I_WIN] + (size_t)l * DM * INC, INC, kb * 64, nb * 32, (bf16_t*)(ws + O_WIN) + ((size_t)l * 3072 + nb * 32) * 2048, 2048, 2048, nullptr, scr, lane); continue; } r -= N_IN;
                if (r < N_UQ) { const int kb = r / 48, nb = r % 48; tconv_item(p.in[I_WUQ] + (size_t)l * QL * 1536, 1536, kb * 64, nb * 32, (bf16_t*)(ws + O_WUQ) + ((size_t)l * 1536 + nb * 32) * 512, 512, 512, p.in[I_GQ] + l * QL, scr, lane); continue; } r -= N_UQ;
                if (r < N_UKV) { const int kb = r / 64, nb = r % 64; tconv_item(p.in[I_WUKV] + (size_t)l * KVL * 2048, 2048, kb * 64, nb * 32, (bf16_t*)(ws + O_WUKV) + ((size_t)l * 2048 + nb * 32) * 256, 256, 256, p.in[I_GKV] + l * KVL, scr, lane); continue; } r -= N_UKV;
                if (r < N_OUT) { const int kb = r / 64, nb = r % 64; tconv_item(p.in[I_WOUT] + (size_t)l * DM * DM, DM, kb * 64, nb * 32, (bf16_t*)(ws + O_WOUT) + ((size_t)l * 2048 + nb * 32) * 2048, 2048, 2048, nullptr, scr, lane); continue; } r -= N_OUT;
                if (r < 2 * N_G) { const int up = r >= N_G ? 1 : 0; if (up) r -= N_G; const int e = r / 512, q = r % 512, kb = q / 16, nb = q % 16, f0 = nb * 32;
                    const float* src = (up ? p.in[I_WUP] : p.in[I_WGATE]) + ((size_t)l * NEXP + e) * DM * DE;
                    tconv_item(src, DE, kb * 64, f0, (bf16_t*)(ws + O_WGU) + (((size_t)l * NEXP + e) * 1024 + (f0 >> 7) * 256 + up * 128 + (f0 & 127)) * 2048, 2048, 2048, nullptr, scr, lane); continue; } r -= 2 * N_G;
                { const int e = r / 512, q = r % 512, kb = q / 64, nb = q % 64;
                    tconv_item(p.in[I_WDOWN] + ((size_t)l * NEXP + e) * DE * DM, DM, kb * 64, nb * 32, (bf16_t*)(ws + O_WD) + (((size_t)l * NEXP + e) * 2048 + nb * 32) * 512, 512, 512, nullptr, scr, lane); }
            }
        }
    }
    PHASE_END
    PHASE_BEGIN
    {
        for (int i = blockIdx.x * 512 + tid; i < 2 * 5 * 6 * DM; i += gridDim.x * 512) { float a = 0.f;
#pragma unroll
            for (int ks = 0; ks < 16; ++ks) a += XB[(size_t)ks * (2 * 5 * 6 * DM) + i];
            MOD[i] = a; }
    }
    PHASE_END

    for (int l = 0; l < NLAYER; ++l) {
        const bool ctx_out = (l < NLAYER - 1);

        PHASE_BEGIN
        {   LAYERPTRS
            int* pcnt = (int*)(ctl + CW_CNT) + (l - 1) * 32 * 64; const int* prte = RTE + (size_t)(l - 1) * MT * 4;
            for (int r = gw; r < MT; r += NGW) {
                const int b = row_batch(r);
                const float* src = (l == 0) ? (r < T ? p.in[I_X] + (size_t)r * DM : p.in[I_CTX] + (size_t)(r - T) * DM) : XB + (size_t)r * DM;
                f32x4 v[8]; float ss = 0.f;
#pragma unroll
                for (int j = 0; j < 8; ++j) v[j] = *(const f32x4*)(src + 4 * lane + 256 * j);
                if (l > 0) {
                    int c_ = lane < 32 ? pcnt[lane * 64] : 0; int padded = (c_ + 255) & ~255; int incl = padded;
                    incl = wave_incl_scan32(incl, lane);
                    const int base_l = incl - padded;
                    const int e1 = __builtin_amdgcn_readfirstlane(prte[r * 4 + 0]), p1 = prte[r * 4 + 1], e2 = __builtin_amdgcn_readfirstlane(prte[r * 4 + 2]), p2 = prte[r * 4 + 3];
                    const int s1 = __builtin_amdgcn_readlane(base_l, e1) + p1, s2 = __builtin_amdgcn_readlane(base_l, e2) + p2;
                    const float* gf = modp(MOD, l - 1, b, 5);
                    const bf16_t* y1 = YE + (size_t)s1 * DM; const bf16_t* y2 = YE + (size_t)s2 * DM;
#pragma unroll
                    for (int j = 0; j < 8; ++j) { const int c0 = 4 * lane + 256 * j; const u32x2 a = *(const u32x2*)(y1 + c0), bb = *(const u32x2*)(y2 + c0); const f32x4 g = *(const f32x4*)(gf + c0);
                        v[j].x += g.x * (__uint_as_float(a.x << 16) + __uint_as_float(bb.x << 16)); v[j].y += g.y * (__uint_as_float(a.x & 0xffff0000u) + __uint_as_float(bb.x & 0xffff0000u));
                        v[j].z += g.z * (__uint_as_float(a.y << 16) + __uint_as_float(bb.y << 16)); v[j].w += g.w * (__uint_as_float(a.y & 0xffff0000u) + __uint_as_float(bb.y & 0xffff0000u));
                        *(f32x4*)(XB + (size_t)r * DM + c0) = v[j]; }
                }
#pragma unroll
                for (int j = 0; j < 8; ++j) ss += v[j].x * v[j].x + v[j].y * v[j].y + v[j].z * v[j].z + v[j].w * v[j].w;
                const float rstd = rsqrtf(wave_sum(ss) * (1.0f / DM) + EPS);
                const float* sh = modp(MOD, l, b, 0); const float* sc = modp(MOD, l, b, 1);
#pragma unroll
                for (int j = 0; j < 8; ++j) { const int c0 = 4 * lane + 256 * j; const f32x4 g = *(const f32x4*)(g_attn + c0), s_ = *(const f32x4*)(sc + c0), h_ = *(const f32x4*)(sh + c0);
                    const f32x4 o = v[j] * rstd * g * (s_ + 1.0f) + h_; u32x2 w; w.x = pk2(o.x, o.y); w.y = pk2(o.z, o.w); *(u32x2*)(H + (size_t)r * DM + c0) = w; }
            }
        }
        PHASE_END

        PHASE_BEGIN
#if OPT_L2
        {
            g8::DenseSched S{(const char*)H, (const char*)(ws + O_WIN) + (size_t)l * 3072 * 2048 * 2, MT / 256, 12, (int)gridDim.x, (int)blockIdx.x, (size_t)256 * 4096, (size_t)256 * 4096};
            EpiL2 E{ZQ, ZKV, KR, ZF, NAQ, NAK, NAV, SSQ, ROPE};
            g8::gemm_phase((LAS unsigned char*)lds_raw, tid, DM, 4096, 4096, S, E);
        }
#else
        {   LAYERPTRS
            const float* w_in = p.in[I_WIN] + (size_t)l * DM * INC;
            auto af = [&](int row, int k) { return bf2f(H[(size_t)row * DM + k]); };
            auto bf = [&](int k, int col) { return w_in[(size_t)k * INC + col]; };
            auto ef = [&](int row, int c0, const float (&v)[8]) {
                bf16_t* dst; float o[8];
#pragma unroll
                for (int j = 0; j < 8; ++j) o[j] = v[j];
                if (c0 < C_ZKV) { dst = ZQ + (size_t)row * QL + c0; float s = 0.f;
#pragma unroll
                    for (int j = 0; j < 8; ++j) s += v[j] * v[j]; SSQ[row * 96 + (c0 >> 3)] = s; }
                else if (c0 < C_ZKR) { dst = ZKV + (size_t)row * KVL + (c0 - C_ZKV); float s = 0.f;
#pragma unroll
                    for (int j = 0; j < 8; ++j) s += v[j] * v[j]; SSQ[row * 96 + (c0 >> 3)] = s; }
                else if (c0 < C_ZF) { dst = KR + (size_t)row * KRD + (c0 - C_ZKR);
                    if (row < T) { const float* rp = ROPE + ((size_t)(row & (SEQ - 1)) * 32 + ((c0 - C_ZKR) >> 1)) * 2;
#pragma unroll
                        for (int j = 0; j < 4; ++j) { const float cs = rp[2 * j], sn = rp[2 * j + 1]; o[2 * j] = v[2 * j] * cs - v[2 * j + 1] * sn; o[2 * j + 1] = v[2 * j] * sn + v[2 * j + 1] * cs; } } }
                else if (c0 < C_NAQ) dst = ZF + (size_t)row * FW + (c0 - C_ZF);
                else if (c0 < C_NAK) dst = NAQ + (size_t)row * NAW + (c0 - C_NAQ);
                else if (c0 < C_NAV) dst = NAK + (size_t)row * NAW + (c0 - C_NAK);
                else dst = NAV + (size_t)row * NAW + (c0 - C_NAV);
                u32x4 w; w.x = pk2(o[0], o[1]); w.y = pk2(o[2], o[3]); w.z = pk2(o[4], o[5]); w.w = pk2(o[6], o[7]); *(u32x4*)dst = w;
            };
            sgemm_phase<false>(ldsf, MT, INC, DM, af, bf, ef);
        }
#endif
        PHASE_END

        PHASE_BEGIN
        {   LAYERPTRS
#if OPT_L3G
            {
                g8::DenseSched S{(const char*)ZQ, (const char*)(ws + O_WUQ) + (size_t)l * 1536 * 512 * 2, (ctx_out ? MT : T) / 256, 6, (int)gridDim.x, (int)blockIdx.x, (size_t)256 * 1024, (size_t)256 * 1024};
                EpiQ E{QB, SSQ, ROPE};
                g8::gemm_phase((LAS unsigned char*)lds_raw, tid, QL, 1024, 1024, S, E);
            }
            {
                g8::DenseSched S{(const char*)ZKV, (const char*)(ws + O_WUKV) + (size_t)l * 2048 * 256 * 2, MT / 256, 8, (int)gridDim.x, (int)blockIdx.x, (size_t)256 * 512, (size_t)256 * 512};
                EpiKV E{KN, VB, SSQ};
                g8::gemm_phase((LAS unsigned char*)lds_raw, tid, KVL, 512, 512, S, E);
            }
            {
                g8::DenseSched S{(const char*)(ws + O_WFA) + (size_t)l * 1024 * 512 * 2, (const char*)ZF, 4, (ctx_out ? MT : T) / 256, (int)gridDim.x, (int)blockIdx.x, (size_t)256 * 1024, (size_t)256 * 1024};
                EpiF1 E{UVL, UVC};
                g8::gemm_phase((LAS unsigned char*)lds_raw, tid, 512, 1024, 1024, S, E);
            }
#else
            {
                const float* g_q = p.in[I_GQ] + l * QL; const float* w_uq = p.in[I_WUQ] + (size_t)l * QL * (NH * DQK);
                auto af = [&](int row, int k) { return bf2f(ZQ[(size_t)row * QL + k]) * g_q[k]; };
                auto bf = [&](int k, int col) { return w_uq[(size_t)k * (NH * DQK) + col]; };
                auto ef = [&](int row, int c0, const float (&v)[8]) {
                    const float rstd = rsqrtf(ssq_q(SSQ, row) * (1.0f / QL) + EPS); float o[8];
#pragma unroll
                    for (int j = 0; j < 8; ++j) o[j] = v[j] * rstd;
                    const int ch = c0 % DQK;
                    if (row < T && ch >= DNOPE) { const float* rp = ROPE + ((size_t)(row & (SEQ - 1)) * 32 + ((ch - DNOPE) >> 1)) * 2;
#pragma unroll
                        for (int j = 0; j < 4; ++j) { const float cs = rp[2 * j], sn = rp[2 * j + 1], x1 = o[2 * j], x2 = o[2 * j + 1]; o[2 * j] = x1 * cs - x2 * sn; o[2 * j + 1] = x1 * sn + x2 * cs; } }
                    u32x4 w; w.x = pk2(o[0], o[1]); w.y = pk2(o[2], o[3]); w.z = pk2(o[4], o[5]); w.w = pk2(o[6], o[7]); *(u32x4*)(QB + (size_t)row * (NH * DQK) + c0) = w;
                };
                sgemm_phase<false>(ldsf, ctx_out ? MT : T, NH * DQK, QL, af, bf, ef);
            }
            {
                const float* g_kv = p.in[I_GKV] + l * KVL; const float* w_ukv = p.in[I_WUKV] + (size_t)l * KVL * (NH * 256);
                auto af = [&](int row, int k) { return bf2f(ZKV[(size_t)row * KVL + k]) * g_kv[k]; };
                auto bf = [&](int k, int col) { return w_ukv[(size_t)k * (NH * 256) + col]; };
                auto ef = [&](int row, int c0, const float (&v)[8]) {
                    const float rstd = rsqrtf(ssq_kv(SSQ, row) * (1.0f / KVL) + EPS);
                    const int h = c0 >> 8, c = c0 & 255;
                    bf16_t* dst = (c < 128) ? KN + ((size_t)row * NH + h) * DNOPE + c : VB + ((size_t)row * NH + h) * DV + (c - 128);
                    u32x4 w; w.x = pk2(v[0] * rstd, v[1] * rstd); w.y = pk2(v[2] * rstd, v[3] * rstd); w.z = pk2(v[4] * rstd, v[5] * rstd); w.w = pk2(v[6] * rstd, v[7] * rstd); *(u32x4*)dst = w;
                };
                sgemm_phase<false>(ldsf, MT, NH * 256, KVL, af, bf, ef);
            }
            {
                const float* wf = WF + (size_t)l * 1024 * 512;
                auto af = [&](int row, int k) { return wf[(size_t)row * 512 + k]; };
                auto bf = [&](int k, int col) { return bf2f(ZF[(size_t)col * FW + k]); };
                auto ef = [&](int j, int n0, const float (&v)[8]) {
                    bf16_t* dst;
                    if (n0 < T) { const int b = n0 >> 11, s = n0 & (SEQ - 1); dst = UVL + ((size_t)b * 512 + (j & 511)) * 4096 + (j >> 9) * SEQ + s; }
                    else { const int n1 = n0 - T, b = n1 >> 8, s = n1 & 255; dst = UVC + ((size_t)b * 512 + (j & 511)) * 512 + (j >> 9) * CTXL + s; }
                    u32x4 w; w.x = pk2(v[0], v[1]); w.y = pk2(v[2], v[3]); w.z = pk2(v[4], v[5]); w.w = pk2(v[6], v[7]); *(u32x4*)dst = w;
                };
                sgemm_phase<true>(ldsf, 1024, ctx_out ? MT : T, 512, af, bf, ef);
            }
#endif
#if OPT_ATT
            {
                const float* rpb = p.in[I_RPB] + (size_t)l * NAH * 15 * 31;
                const float sc = 0.08838834764831845f;
                float* tab = (float*)(lds_raw + at::LDS_ATT_END);
                for (int unit = blockIdx.x; unit < NB * NAH * 8; unit += gridDim.x) {
                    const int b = unit >> 5, h = (unit >> 3) & 3, u4 = unit & 7;
                    __syncthreads();
                    if (tid < 480) { const int d = tid >> 5, c = tid & 31; tab[tid] = c < 31 ? rpb[(h * 15 + d) * 31 + c] * (1.0f / sc) : 0.f; }
                    __syncthreads();
                    const int lo = min(max(4 * u4 - 4, 0), 24), hi_ = min(max(4 * u4 - 1, 0), 24) + 8; int nr = hi_ - lo; nr += nr & 1;
                    const at::KeySrc ks{NAK + h * NAD, nullptr, NAV + h * NAD, NAW, NAW, T + b * CTXL, b * SEQ + lo * 64, 4};
                    const int r = 4 * u4 + (wave >> 1), cq = (wave & 1) * 32 + (lane & 31);
                    const at::NaHook hook{tab, lo, r, min(max(r - 4, 0), 24), cq, min(max(cq - 8, 0), 48), 4 * (lane >> 5)};
                    const size_t qo = (size_t)(b * SEQ + u4 * 256) * NAW + h * NAD;
                    at::attn_unit<8>(NAQ + qo, NAW, ks, 4 + nr, hook, sc * 1.4426950408889634f, 8.0f / sc, ON + qo, NAW, (char*)lds_raw, tid);
                }
            }
#else
            {
                const float* rpb = p.in[I_RPB] + (size_t)l * NAH * 15 * 31;
                float* qs = ldsf + wave * 256;
                const float sc = 0.08838834764831845f;
                for (int task = gw; task < T * NAH; task += NGW) {
                    const int row = task >> 2, h = task & 3, b = row >> 11, s = row & (SEQ - 1), r = s >> 6, cq = s & 63;
                    const int rs = min(max(r - 4, 0), 24), cs = min(max(cq - 8, 0), 48);
                    auto chunk = [&](int kt, const bf16_t*& kn, int& kns, const bf16_t*& kr, int& krs, const bf16_t*& v, int& vs) {
                        const int krow = (kt < CTXL) ? (T + b * CTXL + kt) : (b * SEQ + rs * 64 + (kt - CTXL));
                        kn = NAK + (size_t)krow * NAW + h * NAD; kns = NAW; kr = nullptr; krs = 0; v = NAV + (size_t)krow * NAW + h * NAD; vs = NAW; };
                    auto bias = [&](int key) { if (key < CTXL) return 0.f; const int jl = key - CTXL, kri = jl >> 6, ck = jl & 63;
                        if (ck < cs || ck >= cs + 16) return -1.0e30f; const int drow = rs + kri - r + 7, dcol = min(max(ck - cq + 15, 0), 30); return rpb[(h * 15 + drow) * 31 + dcol]; };
                    naive_attn_row<128, 0>(NAQ + (size_t)row * NAW + h * NAD, sc, CTXL + 512, chunk, bias, ON + (size_t)row * NAW + h * NAD, qs, lane);
                }
            }
#endif
        }
        PHASE_END

        PHASE_BEGIN
        {   LAYERPTRS
#if OPT_ATT
            {
                const float msc = 0.07216878364870323f, nsc = 0.08838834764831845f;
                for (int u = blockIdx.x; u < NB * NH * 8; u += gridDim.x) {
                    const int xcd = u & 7, idx = u >> 3, bh = xcd * 4 + (idx >> 3), qblk = idx & 7, b = bh >> 3, h = bh & 7;
                    const at::KeySrc ks{KN + h * DNOPE, KR, VB + h * DV, NH * DNOPE, NH * DV, T + b * CTXL, b * SEQ, 4};
                    const size_t r0 = (size_t)b * SEQ + qblk * 256;
                    at::attn_unit<12>(QB + (r0 * NH + h) * DQK, NH * DQK, ks, 4 + SEQ / 64, at::NoHook{}, msc * 1.4426950408889634f, 8.0f / msc, OM + r0 * 1024 + h * DV, 1024, (char*)lds_raw, tid);
                }
                if (ctx_out) {
                    for (int u = (int)gridDim.x - 1 - (int)blockIdx.x; u < NB * NH; u += gridDim.x) {
                        const int b = u >> 3, h = u & 7;
                        const at::KeySrc ks{KN + h * DNOPE, KR, VB + h * DV, NH * DNOPE, NH * DV, T + b * CTXL, 0, 4};
                        const size_t r0 = (size_t)T + b * CTXL;
                        at::attn_unit<12>(QB + (r0 * NH + h) * DQK, NH * DQK, ks, 4, at::NoHook{}, msc * 1.4426950408889634f, 8.0f / msc, OM + r0 * 1024 + h * DV, 1024, (char*)lds_raw, tid);
                    }
                    for (int u = (int)gridDim.x - 33 - (int)blockIdx.x; u >= 0 && u < NB * NAH; u += gridDim.x) {
                        const int b = u >> 2, h = u & 3;
                        const at::KeySrc ks{NAK + h * NAD, nullptr, NAV + h * NAD, NAW, NAW, T + b * CTXL, 0, 4};
                        const size_t qo = (size_t)(T + b * CTXL) * NAW + h * NAD;
                        at::attn_unit<8>(NAQ + qo, NAW, ks, 4, at::NoHook{}, nsc * 1.4426950408889634f, 8.0f / nsc, ON + qo, NAW, (char*)lds_raw, tid);
                    }
                }
            }
#else
            float* qs = ldsf + wave * 256;
            const float msc = 0.07216878364870323f;
            for (int task = gw; task < T * NH; task += NGW) {
                const int row = task >> 3, h = task & 7, b = row >> 11;
                auto chunk = [&](int kt, const bf16_t*& kn, int& kns, const bf16_t*& kr, int& krs, const bf16_t*& v, int& vs) {
                    const int krow = (kt < CTXL) ? (T + b * CTXL + kt) : (b * SEQ + (kt - CTXL));
                    kn = KN + ((size_t)krow * NH + h) * DNOPE; kns = NH * DNOPE; kr = KR + (size_t)krow * KRD; krs = KRD; v = VB + ((size_t)krow * NH + h) * DV; vs = NH * DV; };
                auto bias = [&](int) { return 0.f; };
                naive_attn_row<128, 64>(QB + ((size_t)row * NH + h) * DQK, msc, CTXL + SEQ, chunk, bias, OM + (size_t)row * 1024 + h * DV, qs, lane);
            }
            if (ctx_out) {
                for (int task = gw; task < TC * NH; task += NGW) {
                    const int row = T + (task >> 3), h = task & 7, b = (task >> 3) >> 8;
                    auto chunk = [&](int kt, const bf16_t*& kn, int& kns, const bf16_t*& kr, int& krs, const bf16_t*& v, int& vs) {
                        const int krow = T + b * CTXL + kt;
                        kn = KN + ((size_t)krow * NH + h) * DNOPE; kns = NH * DNOPE; kr = KR + (size_t)krow * KRD; krs = KRD; v = VB + ((size_t)krow * NH + h) * DV; vs = NH * DV; };
                    auto bias = [&](int) { return 0.f; };
                    naive_attn_row<128, 64>(QB + ((size_t)row * NH + h) * DQK, msc, CTXL, chunk, bias, OM + (size_t)row * 1024 + h * DV, qs, lane);
                }
                for (int task = gw; task < TC * NAH; task += NGW) {
                    const int row = T + (task >> 2), h = task & 3, b = (task >> 2) >> 8;
                    auto chunk = [&](int kt, const bf16_t*& kn, int& kns, const bf16_t*& kr, int& krs, const bf16_t*& v, int& vs) {
                        const int krow = T + b * CTXL + kt;
                        kn = NAK + (size_t)krow * NAW + h * NAD; kns = NAW; kr = nullptr; krs = 0; v = NAV + (size_t)krow * NAW + h * NAD; vs = NAW; };
                    auto bias = [&](int) { return 0.f; };
                    naive_attn_row<128, 0>(NAQ + (size_t)row * NAW + h * NAD, 0.08838834764831845f, CTXL, chunk, bias, ON + (size_t)row * NAW + h * NAD, qs, lane);
                }
            }
#endif
            __syncthreads();
            const float* bfn = p.in[I_BFNET] + l * FW;
#if OPT_F2
            {
                F2Sched S{(const char*)(ws + O_DFTL), (const char*)UVL, 8, (int)gridDim.x, (int)blockIdx.x, (size_t)256 * 8192, (size_t)256 * 8192, (size_t)512 * 8192};
                EpiF2 E{OF, bfn, 0.001953125f, SEQ, 0};
                g8::gemm_phase((LAS unsigned char*)lds_raw, tid, 2 * SEQ, 8192, 8192, S, E);
            }
            if (ctx_out) {
                F2Sched S{(const char*)(ws + O_DFTC), (const char*)UVC, 1, (int)gridDim.x, (int)blockIdx.x, (size_t)256 * 1024, (size_t)256 * 1024, (size_t)512 * 1024};
                EpiF2 E{OF, bfn, 0.005524271728019903f, CTXL, T};
                g8::gemm_phase((LAS unsigned char*)lds_raw, tid, 2 * CTXL, 1024, 1024, S, E);
            }
#else
            for (int b = 0; b < NB; ++b) {
                auto af = [&](int k, int kk) { const int n = kk & (SEQ - 1); const int idx = (k * n) & (SEQ - 1); return kk < SEQ ? COSL[idx] : -COSL[(idx - SEQ / 4) & (SEQ - 1)]; };
                auto bf = [&](int kk, int j) { return bf2f(UVL[((size_t)b * 512 + j) * 4096 + kk]); };
                auto ef = [&](int k, int j0, const float (&v)[8]) { const float sc = 0.001953125f;
                    float* dst = OF + (size_t)(b * SEQ + k) * FW + j0;
#pragma unroll
                    for (int j = 0; j < 8; ++j) dst[j] = v[j] * sc + bfn[j0 + j]; };
                sgemm_phase<true>(ldsf, SEQ, FW, 2 * SEQ, af, bf, ef);
            }
            if (ctx_out) {
                for (int b = 0; b < NB; ++b) {
                    auto af = [&](int k, int kk) { const int n = kk & (CTXL - 1); const int idx = ((k * n) & (CTXL - 1)) * (SEQ / CTXL); return kk < CTXL ? COSL[idx] : -COSL[(idx - SEQ / 4) & (SEQ - 1)]; };
                    auto bf = [&](int kk, int j) { return bf2f(UVC[((size_t)b * 512 + j) * 512 + kk]); };
                    auto ef = [&](int k, int j0, const float (&v)[8]) { const float sc = 0.005524271728019903f;
                        float* dst = OF + (size_t)(T + b * CTXL + k) * FW + j0;
#pragma unroll
                        for (int j = 0; j < 8; ++j) dst[j] = v[j] * sc + bfn[j0 + j]; };
                    sgemm_phase<true>(ldsf, CTXL, FW, 2 * CTXL, af, bf, ef);
                }
            }
#endif
        }
        PHASE_END

        PHASE_BEGIN
        {   LAYERPTRS
            const float* g_out = p.in[I_GOUT] + l * DM;
            const int rows = ctx_out ? MT : T;
            for (int r = gw; r < rows; r += NGW) {
                float vm[16], vf[8], vn[8]; float s1 = 0.f, s2 = 0.f, s3 = 0.f;
#pragma unroll
                for (int j = 0; j < 4; ++j) { const u32x2 a = *(const u32x2*)(OM + (size_t)r * 1024 + 4 * lane + 256 * j); vm[4 * j] = __uint_as_float(a.x << 16); vm[4 * j + 1] = __uint_as_float(a.x & 0xffff0000u); vm[4 * j + 2] = __uint_as_float(a.y << 16); vm[4 * j + 3] = __uint_as_float(a.y & 0xffff0000u); }
#pragma unroll
                for (int j = 0; j < 2; ++j) { const f32x4 a = *(const f32x4*)(OF + (size_t)r * FW + 4 * lane + 256 * j); vf[4 * j] = a.x; vf[4 * j + 1] = a.y; vf[4 * j + 2] = a.z; vf[4 * j + 3] = a.w; }
#pragma unroll
                for (int j = 0; j < 2; ++j) { const u32x2 a = *(const u32x2*)(ON + (size_t)r * NAW + 4 * lane + 256 * j); vn[4 * j] = __uint_as_float(a.x << 16); vn[4 * j + 1] = __uint_as_float(a.x & 0xffff0000u); vn[4 * j + 2] = __uint_as_float(a.y << 16); vn[4 * j + 3] = __uint_as_float(a.y & 0xffff0000u); }
#pragma unroll
                for (int j = 0; j < 16; ++j) s1 += vm[j] * vm[j];
#pragma unroll
                for (int j = 0; j < 8; ++j) { s2 += vf[j] * vf[j]; s3 += vn[j] * vn[j]; }
                const float r1 = rsqrtf(wave_sum(s1) * (1.0f / 1024.0f) + EPS), r2 = rsqrtf(wave_sum(s2) * (1.0f / 512.0f) + EPS), r3 = rsqrtf(wave_sum(s3) * (1.0f / 512.0f) + EPS);
                bf16_t* yr = Y + (size_t)r * DM;
#pragma unroll
                for (int j = 0; j < 4; ++j) { const int c0 = 4 * lane + 256 * j; const f32x4 g = *(const f32x4*)(g_out + c0); u32x2 w; w.x = pk2(vm[4 * j] * r1 * g.x, vm[4 * j + 1] * r1 * g.y); w.y = pk2(vm[4 * j + 2] * r1 * g.z, vm[4 * j + 3] * r1 * g.w); *(u32x2*)(yr + c0) = w; }
#pragma unroll
                for (int j = 0; j < 2; ++j) { const int c0 = 4 * lane + 256 * j; const f32x4 g = *(const f32x4*)(g_out + 1024 + c0); u32x2 w; w.x = pk2(vf[4 * j] * r2 * g.x, vf[4 * j + 1] * r2 * g.y); w.y = pk2(vf[4 * j + 2] * r2 * g.z, vf[4 * j + 3] * r2 * g.w); *(u32x2*)(yr + 1024 + c0) = w; }
#pragma unroll
                for (int j = 0; j < 2; ++j) { const int c0 = 4 * lane + 256 * j; const f32x4 g = *(const f32x4*)(g_out + 1536 + c0); u32x2 w; w.x = pk2(vn[4 * j] * r3 * g.x, vn[4 * j + 1] * r3 * g.y); w.y = pk2(vn[4 * j + 2] * r3 * g.z, vn[4 * j + 3] * r3 * g.w); *(u32x2*)(yr + 1536 + c0) = w; }
            }
        }
        PHASE_END

        PHASE_BEGIN
#if OPT_L6
        {
            g8::DenseSched S{(const char*)Y, (const char*)(ws + O_WOUT) + (size_t)l * 2048 * 2048 * 2, (ctx_out ? MT : T) / 256, 8, (int)gridDim.x, (int)blockIdx.x, (size_t)256 * 4096, (size_t)256 * 4096};
            EpiOut E{XB, p.in[I_X], p.in[I_CTX], MOD + (size_t)l * 5 * 6 * DM, l};
            g8::gemm_phase((LAS unsigned char*)lds_raw, tid, DM, 4096, 4096, S, E);
        }
#else
        {   LAYERPTRS
            const float* w_out = p.in[I_WOUT] + (size_t)l * DM * DM; const float* x_in = p.in[I_X]; const float* ctx_in = p.in[I_CTX];
            auto af = [&](int row, int k) { return bf2f(Y[(size_t)row * DM + k]); };
            auto bf = [&](int k, int col) { return w_out[(size_t)k * DM + col]; };
            auto ef = [&](int row, int c0, const float (&v)[8]) {
                const int b = row_batch(row); const float* ga = modp(MOD, l, b, 2) + c0;
                const float* xr = (l == 0) ? (row < T ? x_in + (size_t)row * DM : ctx_in + (size_t)(row - T) * DM) : XB + (size_t)row * DM;
                float* dst = XB + (size_t)row * DM + c0;
#pragma unroll
                for (int j = 0; j < 8; ++j) dst[j] = xr[c0 + j] + ga[j] * v[j];
            };
            sgemm_phase<false>(ldsf, ctx_out ? MT : T, DM, DM, af, bf, ef);
        }
#endif
        PHASE_END

        PHASE_BEGIN
        {   LAYERPTRS
            const float* w_rg = p.in[I_WRG] + (size_t)l * DM * NGRP; const float* b_rg = p.in[I_BRG] + l * NGRP;
            const float* w_re = p.in[I_WRE] + (size_t)l * DM * NEXP; const float* b_re = p.in[I_BRE] + l * NEXP;
            const int rows = ctx_out ? MT : T;
            for (int r = gw; r < rows; r += NGW) {
                const int b = row_batch(r);
                f32x4 v[8]; float ss = 0.f;
#pragma unroll
                for (int j = 0; j < 8; ++j) { v[j] = *(const f32x4*)(XB + (size_t)r * DM + 4 * lane + 256 * j); ss += v[j].x * v[j].x + v[j].y * v[j].y + v[j].z * v[j].z + v[j].w * v[j].w; }
                const float rstd = rsqrtf(wave_sum(ss) * (1.0f / DM) + EPS);
                const float* sh = modp(MOD, l, b, 3); const float* sc = modp(MOD, l, b, 4);
                float lg[4], le[32];
#pragma unroll
                for (int j = 0; j < 4; ++j) lg[j] = 0.f;
#pragma unroll
                for (int j = 0; j < 32; ++j) le[j] = 0.f;
#pragma unroll 1
                for (int j = 0; j < 8; ++j) { const int c0 = 4 * lane + 256 * j; const f32x4 g = *(const f32x4*)(g_ffn + c0), s_ = *(const f32x4*)(sc + c0), h_ = *(const f32x4*)(sh + c0);
                    const f32x4 o = v[j] * rstd * g * (s_ + 1.0f) + h_; u32x2 w; w.x = pk2(o.x, o.y); w.y = pk2(o.z, o.w); *(u32x2*)(H + (size_t)r * DM + c0) = w;
#pragma unroll 1
                    for (int t = 0; t < 4; ++t) { const float hv = o[t]; const f32x4 wg = *(const f32x4*)(w_rg + (size_t)(c0 + t) * NGRP);
                        lg[0] = fmaf(hv, wg.x, lg[0]); lg[1] = fmaf(hv, wg.y, lg[1]); lg[2] = fmaf(hv, wg.z, lg[2]); lg[3] = fmaf(hv, wg.w, lg[3]);
                        const f32x4* we = (const f32x4*)(w_re + (size_t)(c0 + t) * NEXP);
#pragma unroll
                        for (int q = 0; q < 8; ++q) { const f32x4 wv = we[q]; le[4 * q] = fmaf(hv, wv.x, le[4 * q]); le[4 * q + 1] = fmaf(hv, wv.y, le[4 * q + 1]); le[4 * q + 2] = fmaf(hv, wv.z, le[4 * q + 2]); le[4 * q + 3] = fmaf(hv, wv.w, le[4 * q + 3]); } } }
#pragma unroll
                for (int j = 0; j < 4; ++j) lg[j] = wave_sum(lg[j]) + b_rg[j];
#pragma unroll
                for (int j = 0; j < 32; ++j) le[j] = wave_sum(le[j]) + b_re[j];
                int gsel = 0; float mg = lg[0];
#pragma unroll
                for (int j = 1; j < 4; ++j) if (lg[j] > mg) { mg = lg[j]; gsel = j; }
                float sg = 0.f;
#pragma unroll
                for (int j = 0; j < 4; ++j) sg += __expf(lg[j] - mg);
                const float g_w = 1.0f / sg;
                float l8[8];
#pragma unroll
                for (int i = 0; i < 8; ++i) l8[i] = gsel == 0 ? le[i] : gsel == 1 ? le[8 + i] : gsel == 2 ? le[16 + i] : le[24 + i];
                int i1 = 0; float m1 = l8[0];
#pragma unroll
                for (int i = 1; i < 8; ++i) if (l8[i] > m1) { m1 = l8[i]; i1 = i; }
                int i2 = -1; float m2 = -3.0e38f;
#pragma unroll
                for (int i = 0; i < 8; ++i) if (i != i1 && l8[i] > m2) { m2 = l8[i]; i2 = i; }
                const float p2 = __expf(m2 - m1);
                const float w1 = g_w / (1.0f + p2), w2 = g_w * p2 / (1.0f + p2);
                if (lane == 0) {
                    const int e1 = gsel * 8 + i1, e2 = gsel * 8 + i2;
                    const int q1 = atomicAdd(&cnt[e1 * 64], 1), q2 = atomicAdd(&cnt[e2 * 64], 1);
                    list[(size_t)e1 * MT + q1] = r; lw[(size_t)e1 * MT + q1] = w1; list[(size_t)e2 * MT + q2] = r; lw[(size_t)e2 * MT + q2] = w2;
                    rte[r * 4 + 0] = e1; rte[r * 4 + 1] = q1; rte[r * 4 + 2] = e2; rte[r * 4 + 3] = q2;
                }
            }
        }
        PHASE_END

        PHASE_BEGIN
#if OPT_MOE
        {   LAYERPTRS
            LAS int* tp = (LAS int*)((LAS unsigned char*)lds_raw + LDS_TAB); LAS int* cn = tp + 33;
            __syncthreads();
            if (tid < 32) cn[tid] = cnt[tid * 64];
            __syncthreads();
            if (tid == 0) { int a = 0; for (int e = 0; e < 32; ++e) { tp[e] = a; a += (cn[e] + 255) >> 8; } tp[32] = a; }
            __syncthreads();
            MoeSched1 S{(const char*)H, (const char*)(ws + O_WGU) + (size_t)l * NEXP * 1024 * 4096, list, tp, cn, (int)gridDim.x, (int)blockIdx.x};
            EpiGU E{HB, lw};
            g8::gemm_phase((LAS unsigned char*)lds_raw, tid, DM, 4096, 4096, S, E);
        }
#else
        {   LAYERPTRS
            int* s_base = (int*)(lds_raw + 65536);
            __syncthreads();
            if (tid == 0) { int a = 0; for (int e = 0; e < 32; ++e) { s_base[e] = a; a += (cnt[e * 64] + 255) & ~255; } s_base[32] = a; }
            __syncthreads();
            const float* w_gate = p.in[I_WGATE] + (size_t)l * NEXP * DM * DE; const float* w_up = p.in[I_WUP] + (size_t)l * NEXP * DM * DE;
            int tbase = 0;
            for (int e = 0; e < 32; ++e) {
                const int ce = cnt[e * 64], tm = (ce + 127) / 128, nt = tm * 8;
                const int* le_ = list + (size_t)e * MT; const float* lwe = lw + (size_t)e * MT; const int sb = s_base[e];
                const float* wg = w_gate + (size_t)e * DM * DE; const float* wu = w_up + (size_t)e * DM * DE;
                auto af = [&](int i, int k) { return bf2f(H[(size_t)le_[i] * DM + k]); };
                auto bf = [&](int k, int col) { return (col & 1) ? wu[(size_t)k * DE + (col >> 1)] : wg[(size_t)k * DE + (col >> 1)]; };
                auto ef = [&](int i, int c0, const float (&v)[8]) { const float w = lwe[i];
                    u32x2 o; o.x = pk2(silu(v[0]) * v[1] * w, silu(v[2]) * v[3] * w); o.y = pk2(silu(v[4]) * v[5] * w, silu(v[6]) * v[7] * w); *(u32x2*)(HB + (size_t)(sb + i) * DE + (c0 >> 1)) = o; };
                int first = ((int)blockIdx.x - tbase) % (int)gridDim.x; if (first < 0) first += gridDim.x;
                for (int t = first; t < nt; t += gridDim.x) sgemm_tile<false>(ldsf, (t >> 3) * 128, (t & 7) * 128, ce, 1024, DM, af, bf, ef);
                tbase += nt;
            }
        }
#endif
        PHASE_END

        PHASE_BEGIN
#if OPT_MOE
        {   LAYERPTRS
            LAS int* tp = (LAS int*)((LAS unsigned char*)lds_raw + LDS_TAB); LAS int* cn = tp + 33;
            __syncthreads();
            if (tid < 32) cn[tid] = cnt[tid * 64];
            __syncthreads();
            if (tid == 0) { int a = 0; for (int e = 0; e < 32; ++e) { tp[e] = a; a += (cn[e] + 255) >> 8; } tp[32] = a; }
            __syncthreads();
            MoeSched2 S{(const char*)HB, (const char*)(ws + O_WD) + (size_t)l * NEXP * 2048 * 1024, tp, cn, (int)gridDim.x, (int)blockIdx.x};
            EpiDN E{YE};
            g8::gemm_phase((LAS unsigned char*)lds_raw, tid, DE, 1024, 1024, S, E);
        }
#else
        {   LAYERPTRS
            int* s_base2 = (int*)(lds_raw + 65536);
            __syncthreads();
            if (tid == 0) { int a = 0; for (int e = 0; e < 32; ++e) { s_base2[e] = a; a += (cnt[e * 64] + 255) & ~255; } s_base2[32] = a; }
            __syncthreads();
            const float* w_down = p.in[I_WDOWN] + (size_t)l * NEXP * DE * DM;
            int tbase = 0;
            for (int e = 0; e < 32; ++e) {
                const int ce = cnt[e * 64], tm = (ce + 127) / 128, nt = tm * 16; const int sb = s_base2[e];
                const float* wd = w_down + (size_t)e * DE * DM;
                auto af = [&](int i, int k) { return bf2f(HB[(size_t)(sb + i) * DE + k]); };
                auto bf = [&](int k, int col) { return wd[(size_t)k * DM + col]; };
                auto ef = [&](int i, int c0, const float (&v)[8]) { u32x4 w; w.x = pk2(v[0], v[1]); w.y = pk2(v[2], v[3]); w.z = pk2(v[4], v[5]); w.w = pk2(v[6], v[7]); *(u32x4*)(YE + (size_t)(sb + i) * DM + c0) = w; };
                int first = ((int)blockIdx.x - tbase) % (int)gridDim.x; if (first < 0) first += gridDim.x;
                for (int t = first; t < nt; t += gridDim.x) sgemm_tile<false>(ldsf, (t >> 4) * 128, (t & 15) * 128, ce, DM, DE, af, bf, ef);
                tbase += nt;
            }
        }
#endif
        PHASE_END
    }

    PHASE_BEGIN
    {
        const int l = NLAYER - 1;
        int* pcnt = (int*)(ctl + CW_CNT) + l * 32 * 64; const int* prte = RTE + (size_t)l * MT * 4;
        const float* gfin = p.in[I_GFINAL];
        for (int r = gw; r < T; r += NGW) {
            const int b = row_batch(r);
            f32x4 v[8]; float ss = 0.f;
#pragma unroll
            for (int j = 0; j < 8; ++j) v[j] = *(const f32x4*)(XB + (size_t)r * DM + 4 * lane + 256 * j);
            int c_ = lane < 32 ? pcnt[lane * 64] : 0; int padded = (c_ + 255) & ~255; int incl = padded;
            incl = wave_incl_scan32(incl, lane);
            const int base_l = incl - padded;
            const int e1 = __builtin_amdgcn_readfirstlane(prte[r * 4 + 0]), p1 = prte[r * 4 + 1], e2 = __builtin_amdgcn_readfirstlane(prte[r * 4 + 2]), p2 = prte[r * 4 + 3];
            const int s1 = __builtin_amdgcn_readlane(base_l, e1) + p1, s2 = __builtin_amdgcn_readlane(base_l, e2) + p2;
            const float* gf = modp(MOD, l, b, 5);
            const bf16_t* y1 = YE + (size_t)s1 * DM; const bf16_t* y2 = YE + (size_t)s2 * DM;
#pragma unroll
            for (int j = 0; j < 8; ++j) { const int c0 = 4 * lane + 256 * j; const u32x2 a = *(const u32x2*)(y1 + c0), bb = *(const u32x2*)(y2 + c0); const f32x4 g = *(const f32x4*)(gf + c0);
                v[j].x += g.x * (__uint_as_float(a.x << 16) + __uint_as_float(bb.x << 16)); v[j].y += g.y * (__uint_as_float(a.x & 0xffff0000u) + __uint_as_float(bb.x & 0xffff0000u));
                v[j].z += g.z * (__uint_as_float(a.y << 16) + __uint_as_float(bb.y << 16)); v[j].w += g.w * (__uint_as_float(a.y & 0xffff0000u) + __uint_as_float(bb.y & 0xffff0000u));
                ss += v[j].x * v[j].x + v[j].y * v[j].y + v[j].z * v[j].z + v[j].w * v[j].w; }
            const float rstd = rsqrtf(wave_sum(ss) * (1.0f / DM) + EPS);
#pragma unroll
            for (int j = 0; j < 8; ++j) { const int c0 = 4 * lane + 256 * j; const f32x4 g = *(const f32x4*)(gfin + c0); *(f32x4*)(p.out + (size_t)r * DM + c0) = v[j] * rstd * g; }
        }
    }
    PHASE_END
#undef PHASE_BEGIN
#undef PHASE_END
}

constexpr int NPHASES = 2 + 9 * NLAYER + 1;

extern "C" void kernel_launch(void* const* d_in, const int* in_sizes, int n_in, void* d_out, int out_size, void* d_ws, size_t ws_size, hipStream_t stream) {
    static int grid = 0;
    if (grid == 0) {
        if (n_in != 26 || out_size != T * DM || ws_size < WS_END) { fprintf(stderr, "kernel_launch: unexpected shapes (n_in %d out %d ws %zu need %zu)\n", n_in, out_size, ws_size, (size_t)WS_END); grid = -1; return; }
        int dev = 0, cus = 0, per_cu = 0;
        if (hipGetDevice(&dev) != hipSuccess || hipDeviceGetAttribute(&cus, hipDeviceAttributeMultiprocessorCount, dev) != hipSuccess) { grid = -1; return; }
        if (hipFuncSetAttribute((const void*)fwd_kernel, hipFuncAttributeMaxDynamicSharedMemorySize, LDS_BYTES) != hipSuccess) { fprintf(stderr, "kernel_launch: hipFuncSetAttribute failed\n"); grid = -1; return; }
        if (hipOccupancyMaxActiveBlocksPerMultiprocessor(&per_cu, (const void*)fwd_kernel, 512, LDS_BYTES) != hipSuccess || per_cu < 1) { fprintf(stderr, "kernel_launch: occupancy query says %d\n", per_cu); }
        (void)hipGetLastError();
        grid = cus;
    }
    if (grid < 0) return;
    (void)hipMemsetAsync(d_ws, 0, CTL_BYTES, stream);
    Params p{};
    for (int i = 0; i < 26; ++i) p.in[i] = (const float*)d_in[i];
    p.out = (float*)d_out; p.ws = (unsigned char*)d_ws;
#if ONE_LAUNCH
    p.ph_lo = 0; p.ph_hi = NPHASES;
    hipLaunchKernelGGL(fwd_kernel, dim3(grid), dim3(512), LDS_BYTES, stream, p);
#else
    for (int ph = 0; ph < NPHASES; ++ph) { p.ph_lo = ph; p.ph_hi = ph + 1; hipLaunchKernelGGL(fwd_kernel, dim3(grid), dim3(512), LDS_BYTES, stream, p); }
#endif
}
```

```cpp
#include <hip/hip_runtime.h>
#include <cstdio>
#include <cstdint>

#ifndef ONE_LAUNCH
#define ONE_LAUNCH 1
#endif

#ifndef OPT_L2
#define OPT_L2 1
#endif
#ifndef OPT_L3G
#define OPT_L3G 1
#endif
#ifndef OPT_F2
#define OPT_F2 1
#endif
#ifndef OPT_L6
#define OPT_L6 1
#endif
#ifndef OPT_MOE
#define OPT_MOE 1
#endif
#ifndef OPT_ATT
#define OPT_ATT 1
#endif
#ifndef REPEAT_MASK
#define REPEAT_MASK 0u
#endif
#define LAS __attribute__((address_space(3)))
typedef unsigned short bf16_t;
typedef float f32x4 __attribute__((ext_vector_type(4)));
typedef unsigned u32x4 __attribute__((ext_vector_type(4)));
typedef unsigned u32x2 __attribute__((ext_vector_type(2)));

constexpr int DM = 2048, NB = 4, SEQ = 2048, CTXL = 256, NLAYER = 2;
constexpr int T = NB * SEQ, TC = NB * CTXL, MT = T + TC;
constexpr int GW = 64;
constexpr int QL = 512, KVL = 256, KRD = 64, FW = 512, NAW = 512, INC = 2880;
constexpr int NH = 8, DQK = 192, DNOPE = 128, DV = 128, NAH = 4, NAD = 128;
constexpr int NGRP = 4, EPG = 8, NEXP = 32, DE = 512;
constexpr int C_ZQ = 0, C_ZKV = 512, C_ZKR = 768, C_ZF = 832, C_NAQ = 1344, C_NAK = 1856, C_NAV = 2368;
constexpr float EPS = 1e-6f;
constexpr int SLOTS = 26624;

constexpr size_t al256(size_t x) { return (x + 255) & ~(size_t)255; }
constexpr size_t CTL_BYTES = 2u << 20;
constexpr int CW_BAR = 4096;
constexpr int CW_CNT = 65536;
constexpr size_t CB_MOD = 1u << 20;
constexpr size_t O_ROPE = CTL_BYTES;
constexpr size_t O_COSL = O_ROPE + (size_t)SEQ * 32 * 2 * 4;
constexpr size_t O_WF   = al256(O_COSL + SEQ * 4);
constexpr size_t O_SSQ  = O_WF + (size_t)2 * 1024 * 512 * 4;
constexpr size_t O_RTE  = O_SSQ + (size_t)MT * 96 * 4;
constexpr size_t O_LIST = O_RTE + (size_t)2 * MT * 4 * 4;
constexpr size_t O_LW   = O_LIST + (size_t)2 * 32 * MT * 4;
constexpr size_t O_H    = al256(O_LW + (size_t)2 * 32 * MT * 4);
constexpr size_t O_XB   = O_H + (size_t)MT * DM * 2;
constexpr size_t O_HB   = O_XB + (size_t)MT * DM * 4;
constexpr size_t O_ZQ   = O_HB + (size_t)SLOTS * DE * 2;
constexpr size_t O_ZKV  = O_ZQ + (size_t)MT * QL * 2;
constexpr size_t O_KR   = O_ZKV + (size_t)MT * KVL * 2;
constexpr size_t O_ZF   = O_KR + (size_t)MT * KRD * 2;
constexpr size_t O_NAQ  = O_ZF + (size_t)MT * FW * 2;
constexpr size_t O_NAK  = O_NAQ + (size_t)MT * NAW * 2;
constexpr size_t O_NAV  = O_NAK + (size_t)MT * NAW * 2;
constexpr size_t O_QB   = O_NAV + (size_t)MT * NAW * 2;
constexpr size_t O_KN   = O_QB + (size_t)MT * NH * DQK * 2;
constexpr size_t O_VB   = O_KN + (size_t)MT * NH * DNOPE * 2;
constexpr size_t O_UVL  = O_VB + (size_t)MT * NH * DV * 2;
constexpr size_t O_UVC  = O_UVL + (size_t)NB * 512 * 4096 * 2;
constexpr size_t O_OM   = O_UVC + (size_t)NB * 512 * 512 * 2;
constexpr size_t O_OF   = O_OM + (size_t)MT * 1024 * 2;
constexpr size_t O_ON   = O_OF + (size_t)4 * MT * FW * 4;
constexpr size_t O_Y    = O_ON + (size_t)MT * NAW * 2;
constexpr size_t O_ACT_END = O_Y + (size_t)MT * DM * 2;
constexpr size_t O_YE   = O_ZQ;
static_assert(O_YE + (size_t)SLOTS * DM * 2 <= O_ACT_END, "YE overlay");
constexpr size_t O_WIN  = al256(O_ACT_END);
constexpr size_t O_WUQ  = O_WIN + (size_t)2 * 3072 * 2048 * 2;
constexpr size_t O_WUKV = O_WUQ + (size_t)2 * 1536 * 512 * 2;
constexpr size_t O_WOUT = O_WUKV + (size_t)2 * 2048 * 256 * 2;
constexpr size_t O_WGU  = O_WOUT + (size_t)2 * 2048 * 2048 * 2;
constexpr size_t O_WD   = O_WGU + (size_t)2 * 32 * 1024 * 2048 * 2;
constexpr size_t O_WFA  = O_WD + (size_t)2 * 32 * 2048 * 512 * 2;
constexpr size_t O_DFTL = O_WFA + (size_t)2 * 1024 * 512 * 2;
constexpr size_t O_DFTC = O_DFTL + (size_t)2048 * 4096 * 2;
constexpr size_t WS_END = O_DFTC + (size_t)256 * 512 * 2;

constexpr int LDS_BYTES = 147456;
constexpr int LDS_MISC = 147456 - 256;

__device__ __forceinline__ float bf2f(bf16_t b) { return __uint_as_float(((unsigned)b) << 16); }
__device__ __forceinline__ bf16_t f2bf(float f) { unsigned u = __float_as_uint(f); u += 0x7fffu + ((u >> 16) & 1u); return (bf16_t)(u >> 16); }
__device__ __forceinline__ unsigned pk2(float lo, float hi) { return (unsigned)f2bf(lo) | ((unsigned)f2bf(hi) << 16); }
__device__ __forceinline__ int my_lane() { int l; asm volatile("v_mbcnt_lo_u32_b32 %0, -1, 0\n\tv_mbcnt_hi_u32_b32 %0, -1, %0" : "=v"(l)); return l; }
__device__ __forceinline__ float shx(float v, int mask, int lane) { return __int_as_float(__builtin_amdgcn_ds_bpermute((lane ^ mask) << 2, __float_as_int(v))); }
__device__ __forceinline__ float wave_sum(float v) {
    const int l = my_lane();
#pragma unroll
    for (int o = 1; o < 64; o <<= 1) v += shx(v, o, l);
    return v;
}
__device__ __forceinline__ float wave_max(float v) {
    const int l = my_lane();
#pragma unroll
    for (int o = 1; o < 64; o <<= 1) v = fmaxf(v, shx(v, o, l));
    return v;
}
__device__ __forceinline__ int wave_incl_scan32(int v, int lane) {
#pragma unroll
    for (int o = 1; o < 32; o <<= 1) { const int t_ = __builtin_amdgcn_ds_bpermute(((lane - o) & 63) << 2, v); if (lane >= o) v += t_; }
    return v;
}
__device__ __forceinline__ float silu(float x) { return x / (1.0f + __expf(-x)); }

#define XB_TMO      128
#define XB_XCNT(j)  (256  + 64 * (j))
#define XB_XSUB(j)  (1280 + 64 * (j))
#define XB_XGEN(j)  (2304 + 64 * (j))
#define XB_TOP      3328
#define XB_TOPGEN   3392
#define XCD_BAR_WORDS 3456
#define XB_SPIN_CAP (1u << 18)

__device__ __forceinline__ unsigned xb_ld(unsigned* p)              { return __hip_atomic_load(p, __ATOMIC_RELAXED, __HIP_MEMORY_SCOPE_AGENT); }
__device__ __forceinline__ unsigned xb_add(unsigned* p, unsigned v) { return __hip_atomic_fetch_add(p, v, __ATOMIC_RELAXED, __HIP_MEMORY_SCOPE_AGENT); }
__device__ __forceinline__ unsigned xb_xcc_id() { return (unsigned)__builtin_amdgcn_s_getreg((3 << 11) | 20) & 0xFu; }
#define XB_SPIN(cond, bar) do { unsigned _sp = 0; while (cond) { __builtin_amdgcn_s_sleep(1); \
    if ((++_sp & 255u) == 0u) { if (xb_ld(&(bar)[XB_TMO])) break; if (_sp > XB_SPIN_CAP) { atomicAdd(&(bar)[XB_TMO], 1u); break; } } } } while (0)

struct XcdBarrier { unsigned* bar; unsigned x; volatile LAS unsigned* st; };

__device__ __forceinline__ XcdBarrier xcd_barrier_post(unsigned* bar, volatile LAS unsigned* st) {
    XcdBarrier b; b.bar = bar; b.x = xb_xcc_id(); b.st = st;
    if (threadIdx.x == 0) (void)xb_add(&bar[XB_XCNT(b.x)], 1u);
    return b;
}
__device__ __forceinline__ void xcd_barrier_complete(unsigned* bar, unsigned x, unsigned& nloc, unsigned& nx) {
    const unsigned G = gridDim.x * gridDim.y * gridDim.z;
    unsigned sum, cnt, mine, sp = 0u;
    for (;;) {
        sum = 0u; cnt = 0u; mine = 0u;
#pragma unroll
        for (unsigned j = 0; j < 16; ++j) { const unsigned c = xb_ld(&bar[XB_XCNT(j)]); sum += c; cnt += (c > 0u) ? 1u : 0u; mine = (j == x) ? c : mine; }
        if (sum == G) break;
        __builtin_amdgcn_s_sleep(1);
        if ((++sp & 255u) == 0u) { if (xb_ld(&bar[XB_TMO])) break; if (sp > XB_SPIN_CAP) { atomicAdd(&bar[XB_TMO], 1u); break; } }
    }
    nloc = mine > 0u ? mine : 1u; nx = cnt > 0u ? cnt : 1u;
}
template <bool FIRST> __device__ __forceinline__ void xcd_barrier(const XcdBarrier& b, const int tid_) {
    asm volatile("s_waitcnt vmcnt(0)" ::: "memory");
    __syncthreads();
    if (tid_ == 0) {
        unsigned* bar = b.bar;
        __builtin_amdgcn_s_waitcnt(0);
        unsigned nloc = b.st[0], nx = b.st[1];
        if (FIRST) { if (nloc == 0u) { xcd_barrier_complete(bar, b.x, nloc, nx); b.st[0] = nloc; b.st[1] = nx; } }
        const unsigned old = xb_add(&bar[XB_XSUB(b.x)], 1u);
        const unsigned gen = old / nloc;
        if (old + 1u == (gen + 1u) * nloc) {
            __builtin_amdgcn_fence(__ATOMIC_RELEASE, "agent");
            asm volatile("s_waitcnt vmcnt(0)" ::: "memory");
            const unsigned og = xb_add(&bar[XB_TOP], 1u);
            const unsigned tg = og / nx;
            if (og + 1u == (tg + 1u) * nx) xb_add(&bar[XB_TOPGEN], 1u);
            else XB_SPIN(xb_ld(&bar[XB_TOPGEN]) == tg, bar);
            __builtin_amdgcn_fence(__ATOMIC_ACQUIRE, "agent");
            xb_add(&bar[XB_XGEN(b.x)], 1u);
            asm volatile("s_waitcnt vmcnt(0)" ::: "memory");
        } else {
            XB_SPIN(xb_ld(&bar[XB_XGEN(b.x)]) == gen, bar);
            __builtin_amdgcn_fence(__ATOMIC_ACQUIRE, "agent");
            asm volatile("s_waitcnt vmcnt(0)" ::: "memory");
        }
    }
    __syncthreads();
}

struct Params { const float* in[26]; float* out; unsigned char* ws; int ph_lo, ph_hi; };
enum { I_X = 0, I_C, I_CTX, I_CCTX, I_WADA, I_BADA, I_GATTN, I_GFFN, I_WIN, I_GQ, I_WUQ, I_GKV, I_WUKV, I_WFNET, I_BFNET, I_RPB, I_GOUT, I_WOUT,
       I_WRG, I_BRG, I_WRE, I_BRE, I_WGATE, I_WUP, I_WDOWN, I_GFINAL };

__device__ __forceinline__ const float* modp(const float* MOD, int l, int b, int which) { return MOD + ((size_t)(l * 5 + b) * 6 + which) * DM; }
__device__ __forceinline__ int row_batch(int r) { return r < T ? (r >> 11) : 4; }

template <bool BT, class AF, class BF, class EF>
__device__ __forceinline__ void sgemm_tile(float* lds, int m0, int n0, int M, int N, int K, const AF& af, const BF& bf, const EF& ef) {
    float* As = lds; float* Bs = lds + 16 * 132;
    const int tid = threadIdx.x, ty = tid >> 4, tx = tid & 15;
    float acc[4][8];
#pragma unroll
    for (int i = 0; i < 4; ++i)
#pragma unroll
        for (int j = 0; j < 8; ++j) acc[i][j] = 0.f;
    for (int k0 = 0; k0 < K; k0 += 16) {
#pragma unroll
        for (int i = 0; i < 4; ++i) { const int e = tid + i * 512, row = e >> 4, kk = e & 15; float v = 0.f; if (m0 + row < M) v = af(m0 + row, k0 + kk); As[kk * 132 + row] = v; }
#pragma unroll
        for (int i = 0; i < 4; ++i) { const int e = tid + i * 512; int kk, col; if (BT) { col = e >> 4; kk = e & 15; } else { kk = e >> 7; col = e & 127; }
            float v = 0.f; if (n0 + col < N) v = bf(k0 + kk, n0 + col); Bs[kk * 132 + col] = v; }
        __syncthreads();
#pragma unroll 2
        for (int kk = 0; kk < 16; ++kk) {
            const f32x4 a = *(const f32x4*)&As[kk * 132 + ty * 4];
            const f32x4 b0 = *(const f32x4*)&Bs[kk * 132 + tx * 8], b1 = *(const f32x4*)&Bs[kk * 132 + tx * 8 + 4];
#pragma unroll
            for (int i = 0; i < 4; ++i) {
#pragma unroll
                for (int j = 0; j < 4; ++j) { acc[i][j] = fmaf(a[i], b0[j], acc[i][j]); acc[i][4 + j] = fmaf(a[i], b1[j], acc[i][4 + j]); }
            }
        }
        __syncthreads();
    }
#pragma unroll
    for (int i = 0; i < 4; ++i) { const int row = m0 + ty * 4 + i; if (row < M && n0 + tx * 8 < N) ef(row, n0 + tx * 8, acc[i]); }
}
template <bool BT, class AF, class BF, class EF>
__device__ __forceinline__ void sgemm_phase(float* lds, int M, int N, int K, const AF& af, const BF& bf, const EF& ef) {
    const int tm = (M + 127) / 128, tn = (N + 127) / 128;
    for (int t = blockIdx.x; t < tm * tn; t += gridDim.x) sgemm_tile<BT>(lds, (t / tn) * 128, (t % tn) * 128, M, N, K, af, bf, ef);
}


namespace g8 {
typedef short bf16x8 __attribute__((ext_vector_type(8)));
constexpr int BM = 256, BK = 64, HALF = 128, HTB = HALF * BK * 2, STAGE_BYTES = 8 * HTB;
__device__ __forceinline__ int lds_byte(int r, int c) { const int st = (r >> 4) * 2 + (c >> 5), rr = r & 15, cc = c & 31, ob = rr * 64 + cc * 2; return st * 1024 + (ob ^ (((ob >> 9) & 1) << 5)); }
__device__ __forceinline__ void stage_rc(int b, int& R, int& C) { const int st = b / 1024, sb = b % 1024, swz = sb ^ (((sb >> 9) & 1) << 5); R = (st >> 1) * 16 + swz / 64; C = (st & 1) * 32 + (swz % 64) / 2; }
__device__ __forceinline__ int perm32(int rho) { const int n = rho >> 4, i = rho & 15; return 8 * (i >> 2) + 4 * n + (i & 3); }
__device__ __forceinline__ unsigned cvt_pk_bf16(float lo, float hi) { unsigned r; asm volatile("v_cvt_pk_bf16_f32 %0, %1, %2" : "=v"(r) : "v"(lo), "v"(hi)); return r; }

struct Unit { const char* A; const char* B; int pm, pn, aux, cnt; };

template <class Epi, class Sched>
__device__ __forceinline__ void gemm_phase(LAS unsigned char* lds, const int tid_in, const int K, const int lda, const int ldb, const Sched& S, const Epi& E) {
    int tid = tid_in; asm volatile("" : "+v"(tid));
    const int wid = __builtin_amdgcn_readfirstlane(tid >> 6), lane = tid & 63, wr = wid >> 2, wc = wid & 3, fr = lane & 15, fq = lane >> 4;
    const int nt = K / BK;
    int Rr[2], Cb[2]; unsigned voffB[2];
#pragma unroll
    for (int i = 0; i < 2; ++i) { int R, C; stage_rc(tid * 16 + i * 8192, R, C); const int Rb = Epi::PERM ? ((R & ~31) + perm32(R & 31)) : R; Rr[i] = R; Cb[i] = C * 2; voffB[i] = (unsigned)(Rb * ldb + C * 2); }
    const size_t kstep = (size_t)(BK * 2);
    const size_t hstepB = (size_t)HALF * ldb;
    const unsigned ldsw = (unsigned)wid * 1024u;
    const int aoff = lds_byte(wr * 64 + fr, fq * 8), boff = lds_byte(wc * 32 + fr, fq * 8);
#define G8_SA(b, h) (((b) * 2 + (h)) * HTB)
#define G8_SB(b, h) ((4 + (b) * 2 + (h)) * HTB)
#define G8_STAGE(bufoff, gbase, voff) do { _Pragma("unroll") for (int _i = 0; _i < 2; ++_i) \
        __builtin_amdgcn_global_load_lds((const unsigned*)((const char*)(gbase) + (voff)[_i]), (LAS unsigned*)(lds + (bufoff) + ldsw + _i * 8192), 16, 0, 0); } while (0)
#define G8_LDA(dst, b, h) do { _Pragma("unroll") for (int m = 0; m < 4; ++m) _Pragma("unroll") for (int k = 0; k < 2; ++k) dst[m][k] = *(const LAS bf16x8*)(lds + G8_SA(b, h) + aoff + m * 2048 + k * 1024); } while (0)
#define G8_LDB(dst, b, h) do { _Pragma("unroll") for (int n = 0; n < 2; ++n) _Pragma("unroll") for (int k = 0; k < 2; ++k) dst[n][k] = *(const LAS bf16x8*)(lds + G8_SB(b, h) + boff + n * 2048 + k * 1024); } while (0)
#define G8_MMA(ai, bj, At, Bt) do { __builtin_amdgcn_s_setprio(1); _Pragma("unroll") for (int m = 0; m < 4; ++m) _Pragma("unroll") for (int n = 0; n < 2; ++n) _Pragma("unroll") for (int k = 0; k < 2; ++k) \
        acc[ai][bj][m][n] = __builtin_amdgcn_mfma_f32_16x16x32_bf16(Bt[n][k], At[m][k], acc[ai][bj][m][n], 0, 0, 0); __builtin_amdgcn_s_setprio(0); } while (0)
#define G8_WAIT_V(n) asm volatile("s_waitcnt vmcnt(" #n ")" ::: "memory")
#define G8_WAIT_L(n) asm volatile("s_waitcnt lgkmcnt(" #n ")" ::: "memory")
#define G8_BAR __builtin_amdgcn_s_barrier()
#define G8_SCHED __builtin_amdgcn_sched_barrier(0)
    Unit cur, nxt; int ui = 0;
    if (!S.next(0, cur)) return;
    f32x4 acc[2][2][4][2];
#define G8_ZERO_ACC() do { _Pragma("unroll") for (int a = 0; a < 2; ++a) _Pragma("unroll") for (int b = 0; b < 2; ++b) _Pragma("unroll") for (int m = 0; m < 4; ++m) _Pragma("unroll") for (int n = 0; n < 2; ++n) { \
        float z0, z1, z2, z3; asm volatile("v_mov_b32 %0, 0\n\tv_mov_b32 %1, 0\n\tv_mov_b32 %2, 0\n\tv_mov_b32 %3, 0" : "=v"(z0), "=v"(z1), "=v"(z2), "=v"(z3)); acc[a][b][m][n] = (f32x4){z0, z1, z2, z3}; } } while (0)
    G8_ZERO_ACC();
    bf16x8 At[4][2], B0[2][2], B1[2][2];
    constexpr int NG = Sched::GATHER ? 2 : 1;
    unsigned cva[NG][2];
    const size_t hstepA = Sched::GATHER ? 0 : (size_t)HALF * lda;
#pragma unroll
    for (int h = 0; h < NG; ++h)
#pragma unroll
        for (int i = 0; i < 2; ++i) cva[h][i] = S.arow(cur, h * HALF + Rr[i], lda) + (unsigned)Cb[i];
    const char* cA = cur.A; const char* cB = cur.B;
    G8_STAGE(G8_SB(0, 0), cB, voffB); G8_STAGE(G8_SB(0, 1), cB + hstepB, voffB); G8_STAGE(G8_SA(0, 0), cA, cva[0]); G8_STAGE(G8_SA(0, 1), cA + hstepA, cva[NG - 1]);
    if (wr == 1) G8_BAR;
    G8_WAIT_V(2); G8_BAR;
    G8_STAGE(G8_SB(1, 0), cB + kstep, voffB); G8_STAGE(G8_SA(1, 0), cA + kstep, cva[0]); G8_STAGE(G8_SB(1, 1), cB + hstepB + kstep, voffB);
    G8_WAIT_V(6); G8_BAR;
    for (;;) {
        const bool has_next = S.next(ui + 1, nxt);
        const char* nA = has_next ? nxt.A : cA; const char* nB = has_next ? nxt.B : cB;
#pragma unroll 1
        for (int t = 0; t < nt; t += 2) {
            const bool last = (t == nt - 2);
            const char* a1 = cA + (size_t)(t + 1) * kstep;
            const char* a2 = last ? nA : cA + (size_t)(t + 2) * kstep; const char* b2 = last ? nB : cB + (size_t)(t + 2) * kstep;
            const char* a3 = a2 + kstep; const char* b3 = b2 + kstep;
            G8_LDB(B0, 0, 0); G8_LDB(B1, 0, 1); G8_SCHED; G8_LDA(At, 0, 0); G8_STAGE(G8_SA(1, 1), a1 + hstepA, cva[NG - 1]);
            if (Sched::GATHER) { if (last && has_next) {
#pragma unroll
                for (int i = 0; i < 2; ++i) { int R, C; stage_rc(tid * 16 + i * 8192, R, C);
#pragma unroll
                    for (int h = 0; h < NG; ++h) cva[h][i] = S.arow(nxt, h * HALF + R, lda) + (unsigned)(C * 2); } } }
            G8_WAIT_V(8); G8_WAIT_L(0); G8_BAR; G8_MMA(0, 0, At, B0); G8_MMA(0, 1, At, B1); G8_BAR; G8_SCHED;
            G8_LDA(At, 0, 1); G8_STAGE(G8_SB(0, 0), b2, voffB); G8_STAGE(G8_SB(0, 1), b2 + hstepB, voffB); G8_STAGE(G8_SA(0, 0), a2, cva[0]);
            G8_WAIT_V(8); G8_WAIT_L(0); G8_BAR; G8_MMA(1, 0, At, B0); G8_MMA(1, 1, At, B1); G8_BAR; G8_SCHED;
            G8_LDB(B0, 1, 0); G8_LDB(B1, 1, 1); G8_SCHED; G8_LDA(At, 1, 0); G8_STAGE(G8_SA(0, 1), a2 + hstepA, cva[NG - 1]);
            G8_WAIT_V(8); G8_WAIT_L(0); G8_BAR; G8_MMA(0, 0, At, B0); G8_MMA(0, 1, At, B1); G8_BAR; G8_SCHED;
            G8_LDA(At, 1, 1); G8_STAGE(G8_SB(1, 0), b3, voffB); G8_STAGE(G8_SB(1, 1), b3 + hstepB, voffB); G8_STAGE(G8_SA(1, 0), a3, cva[0]);
            G8_WAIT_V(8); G8_WAIT_L(0); G8_BAR; G8_MMA(1, 0, At, B0); G8_MMA(1, 1, At, B1); G8_BAR; G8_SCHED;
        }
        if (wr == 0) G8_BAR;
        E(acc, cur, wr, wc, fr, fq);
        if (!has_next) break;
        G8_ZERO_ACC();
        cur = nxt; cA = nA; cB = nB; ++ui;
        if (wr == 1) G8_BAR;
    }
    G8_WAIT_V(0);
    G8_BAR;
#undef G8_ZERO_ACC
#undef G8_SA
#undef G8_SB
#undef G8_STAGE
#undef G8_LDA
#undef G8_LDB
#undef G8_MMA
#undef G8_WAIT_V
#undef G8_WAIT_L
#undef G8_BAR
#undef G8_SCHED
}

struct DenseSched {
    static constexpr bool GATHER = false;
    const char* A; const char* B; int nM, nN, G, c; size_t astep, bstep;
    __device__ __forceinline__ bool next(int i, Unit& u) const { const int L = i * G + c; if (L >= nM * nN) return false; u.pm = L / nN; u.pn = L % nN; u.aux = 0; u.cnt = 256;
        u.A = A + (size_t)u.pm * astep; u.B = B + (size_t)u.pn * bstep; return true; }
    __device__ __forceinline__ unsigned arow(const Unit&, int r, int lda) const { return (unsigned)(r * lda); }
};
}

__device__ __forceinline__ void tconv_item(const float* W, int ldw, int k0, int n0, bf16_t* dst_row0, int ldd, int rowstep, const float* kscale, LAS float* scr, int lane) {
    float lv[32];
#pragma unroll
    for (int i = 0; i < 32; ++i) lv[i] = W[(size_t)(k0 + 2 * i + (lane >> 5)) * ldw + n0 + (lane & 31)];
#pragma unroll
    for (int i = 0; i < 32; ++i) { const int kk = 2 * i + (lane >> 5); float v = lv[i]; if (kscale) v *= kscale[k0 + kk]; scr[kk * 33 + (lane & 31)] = v; }
    asm volatile("s_waitcnt lgkmcnt(0)" ::: "memory");
    const int c = lane & 7;
#pragma unroll
    for (int j = 0; j < 4; ++j) { const int n = (lane >> 3) + 8 * j; const LAS float* sp = scr + (8 * c) * 33 + n;
        u32x4 o; o.x = pk2(sp[0 * 33], sp[1 * 33]); o.y = pk2(sp[2 * 33], sp[3 * 33]); o.z = pk2(sp[4 * 33], sp[5 * 33]); o.w = pk2(sp[6 * 33], sp[7 * 33]);
        *(u32x4*)(dst_row0 + (size_t)n * rowstep + k0 + 8 * c) = o; }
    asm volatile("s_waitcnt lgkmcnt(0)" ::: "memory");
    (void)ldd;
}


#if OPT_L2
constexpr int SSQW = 12;
__device__ __forceinline__ float ssq_q(const float* SSQ, int row) { const f32x4 a = *(const f32x4*)(SSQ + row * 12), b = *(const f32x4*)(SSQ + row * 12 + 4); return ((a.x + a.y) + (a.z + a.w)) + ((b.x + b.y) + (b.z + b.w)); }
__device__ __forceinline__ float ssq_kv(const float* SSQ, int row) { const f32x4 a = *(const f32x4*)(SSQ + row * 12 + 8); return (a.x + a.y) + (a.z + a.w); }
#else
constexpr int SSQW = 96;
__device__ __forceinline__ float ssq_q(const float* SSQ, int row) { float sq = 0.f; for (int i = 0; i < 64; ++i) sq += SSQ[row * 96 + i]; return sq; }
__device__ __forceinline__ float ssq_kv(const float* SSQ, int row) { float sq = 0.f; for (int i = 64; i < 96; ++i) sq += SSQ[row * 96 + i]; return sq; }
#endif

struct EpiL2 {
    static constexpr bool PERM = true;
    bf16_t *ZQ, *ZKV, *KR, *ZF, *NAQ, *NAK, *NAV; float* SSQ; const float* ROPE;
    __device__ __forceinline__ void operator()(const f32x4 (&acc)[2][2][4][2], const g8::Unit& u, int wr, int wc, int fr, int fq) const {
#pragma unroll
        for (int ai = 0; ai < 2; ++ai)
#pragma unroll
            for (int m = 0; m < 4; ++m) {
                const int row = u.pm * 256 + ai * 128 + wr * 64 + m * 16 + fr; float ss = 0.f;
#pragma unroll
                for (int bj = 0; bj < 2; ++bj) {
                    const int c0 = u.pn * 256 + bj * 128 + wc * 32 + 8 * fq; f32x4 v0 = acc[ai][bj][m][0], v1 = acc[ai][bj][m][1]; bf16_t* dst;
                    if (c0 < C_ZKV) { dst = ZQ + (size_t)row * QL + c0; ss += (v0.x * v0.x + v0.y * v0.y) + (v0.z * v0.z + v0.w * v0.w) + (v1.x * v1.x + v1.y * v1.y) + (v1.z * v1.z + v1.w * v1.w); }
                    else if (c0 < C_ZKR) { dst = ZKV + (size_t)row * KVL + (c0 - C_ZKV); ss += (v0.x * v0.x + v0.y * v0.y) + (v0.z * v0.z + v0.w * v0.w) + (v1.x * v1.x + v1.y * v1.y) + (v1.z * v1.z + v1.w * v1.w); }
                    else if (c0 < C_ZF) { dst = KR + (size_t)row * KRD + (c0 - C_ZKR);
                        if (row < T) { const f32x4* rp = (const f32x4*)(ROPE + ((size_t)(row & (SEQ - 1)) * 32 + ((c0 - C_ZKR) >> 1)) * 2); const f32x4 r0 = rp[0], r1 = rp[1];
                            const f32x4 a = v0, b = v1;
                            v0.x = a.x * r0.x - a.y * r0.y; v0.y = a.x * r0.y + a.y * r0.x; v0.z = a.z * r0.z - a.w * r0.w; v0.w = a.z * r0.w + a.w * r0.z;
                            v1.x = b.x * r1.x - b.y * r1.y; v1.y = b.x * r1.y + b.y * r1.x; v1.z = b.z * r1.z - b.w * r1.w; v1.w = b.z * r1.w + b.w * r1.z; } }
                    else if (c0 < C_NAQ) dst = ZF + (size_t)row * FW + (c0 - C_ZF);
                    else if (c0 < C_NAK) dst = NAQ + (size_t)row * NAW + (c0 - C_NAQ);
                    else if (c0 < C_NAV) dst = NAK + (size_t)row * NAW + (c0 - C_NAK);
                    else if (c0 < INC) dst = NAV + (size_t)row * NAW + (c0 - C_NAV);
                    else dst = nullptr;
                    if (dst) { u32x4 w; w.x = g8::cvt_pk_bf16(v0.x, v0.y); w.y = g8::cvt_pk_bf16(v0.z, v0.w); w.z = g8::cvt_pk_bf16(v1.x, v1.y); w.w = g8::cvt_pk_bf16(v1.z, v1.w); *(u32x4*)dst = w; }
                }
                if (u.pn <= 2) { const int ln = fq * 16 + fr; ss += shx(ss, 16, ln); ss += shx(ss, 32, ln); if (fq == 0) SSQ[row * 12 + u.pn * 4 + wc] = ss; }
            }
    }
};

__device__ __forceinline__ u32x4 pack8(const f32x4& v0, const f32x4& v1) { u32x4 w; w.x = g8::cvt_pk_bf16(v0.x, v0.y); w.y = g8::cvt_pk_bf16(v0.z, v0.w); w.z = g8::cvt_pk_bf16(v1.x, v1.y); w.w = g8::cvt_pk_bf16(v1.z, v1.w); return w; }
struct EpiQ {
    static constexpr bool PERM = true;
    bf16_t* QB; const float* SSQ; const float* ROPE;
    __device__ __forceinline__ void operator()(const f32x4 (&acc)[2][2][4][2], const g8::Unit& u, int wr, int wc, int fr, int fq) const {
#pragma unroll
        for (int ai = 0; ai < 2; ++ai)
#pragma unroll
            for (int m = 0; m < 4; ++m) {
                const int row = u.pm * 256 + ai * 128 + wr * 64 + m * 16 + fr; const float rstd = rsqrtf(ssq_q(SSQ, row) * (1.0f / QL) + EPS);
#pragma unroll
                for (int bj = 0; bj < 2; ++bj) {
                    const int c0 = u.pn * 256 + bj * 128 + wc * 32 + 8 * fq, ch = c0 % DQK; f32x4 v0 = acc[ai][bj][m][0] * rstd, v1 = acc[ai][bj][m][1] * rstd;
                    if (row < T && ch >= DNOPE) { const f32x4* rp = (const f32x4*)(ROPE + ((size_t)(row & (SEQ - 1)) * 32 + ((ch - DNOPE) >> 1)) * 2); const f32x4 r0 = rp[0], r1 = rp[1]; const f32x4 a = v0, b = v1;
                        v0.x = a.x * r0.x - a.y * r0.y; v0.y = a.x * r0.y + a.y * r0.x; v0.z = a.z * r0.z - a.w * r0.w; v0.w = a.z * r0.w + a.w * r0.z;
                        v1.x = b.x * r1.x - b.y * r1.y; v1.y = b.x * r1.y + b.y * r1.x; v1.z = b.z * r1.z - b.w * r1.w; v1.w = b.z * r1.w + b.w * r1.z; }
                    *(u32x4*)(QB + (size_t)row * (NH * DQK) + c0) = pack8(v0, v1);
                }
            }
    }
};
struct EpiKV {
    static constexpr bool PERM = true;
    bf16_t *KN, *VB; const float* SSQ;
    __device__ __forceinline__ void operator()(const f32x4 (&acc)[2][2][4][2], const g8::Unit& u, int wr, int wc, int fr, int fq) const {
#pragma unroll
        for (int ai = 0; ai < 2; ++ai)
#pragma unroll
            for (int m = 0; m < 4; ++m) {
                const int row = u.pm * 256 + ai * 128 + wr * 64 + m * 16 + fr; const float rstd = rsqrtf(ssq_kv(SSQ, row) * (1.0f / KVL) + EPS);
                const size_t o = ((size_t)row * NH + u.pn) * 128 + wc * 32 + 8 * fq;
                *(u32x4*)(KN + o) = pack8(acc[ai][0][m][0] * rstd, acc[ai][0][m][1] * rstd);
                *(u32x4*)(VB + o) = pack8(acc[ai][1][m][0] * rstd, acc[ai][1][m][1] * rstd);
            }
    }
};
struct EpiF1 {
    static constexpr bool PERM = true;
    bf16_t *UVL, *UVC;
    __device__ __forceinline__ void operator()(const f32x4 (&acc)[2][2][4][2], const g8::Unit& u, int wr, int wc, int fr, int fq) const {
#pragma unroll
        for (int ai = 0; ai < 2; ++ai)
#pragma unroll
            for (int m = 0; m < 4; ++m) {
                const int j = u.pm * 256 + ai * 128 + wr * 64 + m * 16 + fr;
#pragma unroll
                for (int bj = 0; bj < 2; ++bj) {
                    const int n0 = u.pn * 256 + bj * 128 + wc * 32 + 8 * fq; bf16_t* dst;
                    if (n0 < T) { const int b = n0 >> 11, s_ = n0 & (SEQ - 1); dst = UVL + ((size_t)b * 512 + (j & 511)) * 4096 + (j >> 9) * SEQ + s_; }
                    else { const int n1 = n0 - T, b = n1 >> 8, s_ = n1 & 255; dst = UVC + ((size_t)b * 512 + (j & 511)) * 512 + (j >> 9) * CTXL + s_; }
                    *(u32x4*)dst = pack8(acc[ai][bj][m][0], acc[ai][bj][m][1]);
                }
            }
    }
};
struct EpiF2 {
    static constexpr bool PERM = false;
    float* OF; int rows_per_batch, row_base;
    __device__ __forceinline__ void operator()(const f32x4 (&acc)[2][2][4][2], const g8::Unit& u, int wr, int wc, int fr, int fq) const {
#pragma unroll
        for (int ai = 0; ai < 2; ++ai)
#pragma unroll
            for (int m = 0; m < 4; ++m) {
                const int row = row_base + u.aux * rows_per_batch + u.pm * 256 + ai * 128 + wr * 64 + m * 16 + fr;
#pragma unroll
                for (int bj = 0; bj < 2; ++bj)
#pragma unroll
                    for (int n = 0; n < 2; ++n) { const int col = u.pn * 256 + bj * 128 + wc * 32 + 16 * n + 4 * fq;
                        *(f32x4*)(OF + ((size_t)u.cnt * MT + row) * FW + col) = acc[ai][bj][m][n]; }
            }
    }
};
struct F2Sched {
    static constexpr bool GATHER = false;
    const char* A; const char* B; int nM, nKQ, G, c; size_t astep, bstep, bbatch, kqstep;
    __device__ __forceinline__ bool next(int i, g8::Unit& u) const { const int L = i * G + c; if (L >= NB * nM * 2 * nKQ) return false; const int kq = L % nKQ, L2 = L / nKQ; u.aux = L2 / (nM * 2); const int r = L2 % (nM * 2); u.pm = r >> 1; u.pn = r & 1; u.cnt = kq;
        u.A = A + (size_t)u.pm * astep + (size_t)kq * kqstep; u.B = B + (size_t)u.aux * bbatch + (size_t)u.pn * bstep + (size_t)kq * kqstep; return true; }
    __device__ __forceinline__ unsigned arow(const g8::Unit&, int r, int lda) const { return (unsigned)(r * lda); }
};
struct EpiOut {
    static constexpr bool PERM = false;
    float* XB; const float* x_in; const float* ctx_in; const float* MODl; int l;
    __device__ __forceinline__ void operator()(const f32x4 (&acc)[2][2][4][2], const g8::Unit& u, int wr, int wc, int fr, int fq) const {
#pragma unroll
        for (int ai = 0; ai < 2; ++ai)
#pragma unroll
            for (int m = 0; m < 4; ++m) {
                const int row = u.pm * 256 + ai * 128 + wr * 64 + m * 16 + fr; const int b = row_batch(row);
                const float* xr = (l == 0) ? (row < T ? x_in + (size_t)row * DM : ctx_in + (size_t)(row - T) * DM) : XB + (size_t)row * DM;
                const float* ga = MODl + ((size_t)b * 6 + 2) * DM;
#pragma unroll
                for (int bj = 0; bj < 2; ++bj)
#pragma unroll
                    for (int n = 0; n < 2; ++n) { const int col = u.pn * 256 + bj * 128 + wc * 32 + 16 * n + 4 * fq;
                        *(f32x4*)(XB + (size_t)row * DM + col) = *(const f32x4*)(xr + col) + *(const f32x4*)(ga + col) * acc[ai][bj][m][n]; }
            }
    }
};
constexpr int LDS_TAB = 131072 + 256;
struct MoeSched1 {
    static constexpr bool GATHER = true;
    const char* A; const char* B; const int* list; const LAS int* tp; const LAS int* cn; int G, c;
    __device__ __forceinline__ bool next(int i, g8::Unit& u) const { const int L = i * G + c; if (L >= __builtin_amdgcn_readfirstlane(tp[32]) * 4) return false; const int mt = L >> 2; u.pn = L & 3; int e = 0;
        e = __builtin_amdgcn_readfirstlane(tp[80 + mt]);
        u.aux = e; u.pm = __builtin_amdgcn_readfirstlane(mt - tp[e]); u.cnt = __builtin_amdgcn_readfirstlane(min(256, cn[e] - u.pm * 256) | (mt << 16)); u.A = A; u.B = B + ((size_t)e * 1024 + u.pn * 256) * 4096; return true; }
    __device__ __forceinline__ unsigned arow(const g8::Unit& u, int r, int lda) const { const int i = min(u.pm * 256 + r, cn[u.aux] - 1); return (unsigned)list[(size_t)u.aux * MT + i] * (unsigned)lda; }
};
struct EpiGU {
    static constexpr bool PERM = true;
    bf16_t* HB; const float* lw;
    __device__ __forceinline__ void operator()(const f32x4 (&acc)[2][2][4][2], const g8::Unit& u, int wr, int wc, int fr, int fq) const {
        const int cntu = u.cnt & 0xffff, mt = u.cnt >> 16;
#pragma unroll
        for (int ai = 0; ai < 2; ++ai)
#pragma unroll
            for (int m = 0; m < 4; ++m) {
                const int r = ai * 128 + wr * 64 + m * 16 + fr;
                if (r < cntu) { const float w = lw[(size_t)u.aux * MT + u.pm * 256 + r];
                    const f32x4 g0 = acc[ai][0][m][0], g1 = acc[ai][0][m][1], u0 = acc[ai][1][m][0], u1 = acc[ai][1][m][1]; f32x4 h0, h1;
#pragma unroll
                    for (int e = 0; e < 4; ++e) { h0[e] = g0[e] / (1.0f + __expf(-g0[e])) * u0[e] * w; h1[e] = g1[e] / (1.0f + __expf(-g1[e])) * u1[e] * w; }
                    *(u32x4*)(HB + (size_t)(mt * 256 + r) * DE + u.pn * 128 + wc * 32 + 8 * fq) = pack8(h0, h1); }
            }
    }
};
struct MoeSched2 {
    static constexpr bool GATHER = false;
    const char* A; const char* B; const LAS int* tp; const LAS int* cn; int G, c;
    __device__ __forceinline__ bool next(int i, g8::Unit& u) const { const int L = i * G + c; if (L >= __builtin_amdgcn_readfirstlane(tp[32]) * 8) return false; const int mt = L >> 3; u.pn = L & 7; int e = 0;
        e = __builtin_amdgcn_readfirstlane(tp[80 + mt]);
        u.aux = e; u.pm = mt; u.cnt = __builtin_amdgcn_readfirstlane(min(256, cn[e] - (mt - tp[e]) * 256)); u.A = A + (size_t)mt * 256 * 1024; u.B = B + ((size_t)e * 2048 + u.pn * 256) * 1024; return true; }
    __device__ __forceinline__ unsigned arow(const g8::Unit&, int r, int lda) const { return (unsigned)(r * lda); }
};
struct EpiDN {
    static constexpr bool PERM = true;
    bf16_t* YE;
    __device__ __forceinline__ void operator()(const f32x4 (&acc)[2][2][4][2], const g8::Unit& u, int wr, int wc, int fr, int fq) const {
#pragma unroll
        for (int ai = 0; ai < 2; ++ai)
#pragma unroll
            for (int m = 0; m < 4; ++m) {
                const int r = ai * 128 + wr * 64 + m * 16 + fr;
                if (r < u.cnt) {
#pragma unroll
                    for (int bj = 0; bj < 2; ++bj) *(u32x4*)(YE + (size_t)(u.pm * 256 + r) * DM + u.pn * 256 + bj * 128 + wc * 32 + 8 * fq) = pack8(acc[ai][bj][m][0], acc[ai][bj][m][1]); }
            }
    }
};

namespace at {
typedef short bf16x8 __attribute__((ext_vector_type(8)));
typedef short s16x4 __attribute__((ext_vector_type(4)));
typedef float f32x16 __attribute__((ext_vector_type(16)));
#define AT_SBAR() __builtin_amdgcn_sched_barrier(0)
__device__ __forceinline__ int crow(int r, int hi) { return (r & 3) + 8 * (r >> 2) + 4 * hi; }
__device__ __forceinline__ unsigned cvtpk(float lo, float hi) { unsigned r; asm volatile("v_cvt_pk_bf16_f32 %0, %1, %2" : "=v"(r) : "v"(lo), "v"(hi)); return r; }
template <int DKB> __device__ __forceinline__ int koff(int row, int cb) {
    if (DKB == 256) return row * 256 + (cb ^ ((row & 15) << 4));
    else return row * 384 + (cb ^ (((row >> 1) & 7) << 4));
}
__device__ __forceinline__ void partialSM(f32x16& p0, f32x16& p1, float& m_reg, float& mn, float& alpha, const float C, const float THRS) {
    float pmax = p0[0];
#pragma unroll
    for (int r = 1; r < 16; ++r) pmax = fmaxf(pmax, p0[r]);
#pragma unroll
    for (int r = 0; r < 16; ++r) pmax = fmaxf(pmax, p1[r]);
    { auto rr = __builtin_amdgcn_permlane32_swap(__float_as_uint(pmax), __float_as_uint(pmax), false, false); pmax = fmaxf(__uint_as_float(rr[0]), __uint_as_float(rr[1])); }
    if (__builtin_expect(__all(pmax - m_reg <= THRS), 1)) { mn = m_reg; alpha = 1.f; }
    else { mn = fmaxf(m_reg, pmax); alpha = __builtin_amdgcn_exp2f((m_reg - mn) * C); m_reg = mn; }
    const float mnC = -mn * C;
#pragma unroll
    for (int r = 0; r < 16; ++r) p0[r] = fmaf(p0[r], C, mnC);
#pragma unroll
    for (int r = 0; r < 16; ++r) p1[r] = fmaf(p1[r], C, mnC);
#pragma unroll
    for (int r = 0; r < 16; ++r) p0[r] = __builtin_amdgcn_exp2f(p0[r]);
}
__device__ __forceinline__ void finishSM(f32x16& p0, f32x16& p1, float alpha, float& l_reg, bf16x8& pa0, bf16x8& pa1, bf16x8& pa2, bf16x8& pa3) {
#pragma unroll
    for (int r = 0; r < 16; ++r) p1[r] = __builtin_amdgcn_exp2f(p1[r]);
    float ps = 0;
#pragma unroll
    for (int r = 0; r < 16; ++r) ps += p0[r];
#pragma unroll
    for (int r = 0; r < 16; ++r) ps += p1[r];
    { auto rr = __builtin_amdgcn_permlane32_swap(__float_as_uint(ps), __float_as_uint(ps), false, false); ps = __uint_as_float(rr[0]) + __uint_as_float(rr[1]); }
    l_reg = l_reg * alpha + ps;
#define AT_PK4(P, BASE, OUT) do { unsigned a0 = cvtpk(P[BASE + 0], P[BASE + 1]), a1 = cvtpk(P[BASE + 2], P[BASE + 3]);   \
    unsigned b0 = cvtpk(P[BASE + 4], P[BASE + 5]), b1 = cvtpk(P[BASE + 6], P[BASE + 7]);                              \
    auto r0 = __builtin_amdgcn_permlane32_swap(a0, b0, false, false); auto r1 = __builtin_amdgcn_permlane32_swap(a1, b1, false, false); \
    u32x4 w = {r0[0], r1[0], r0[1], r1[1]}; OUT = *reinterpret_cast<bf16x8*>(&w); } while (0)
    AT_PK4(p0, 0, pa0); AT_PK4(p0, 8, pa1); AT_PK4(p1, 0, pa2); AT_PK4(p1, 8, pa3);
#undef AT_PK4
}
template <int ND0, int DKB>
__device__ __forceinline__ void qkt(f32x16& p0, f32x16& p1, const char* Ks, const bf16x8 (&qr)[ND0], int r32, int hi) {
    p0 = f32x16{}; p1 = f32x16{};
#pragma unroll
    for (int d0 = 0; d0 < ND0; ++d0) { const int cb = (d0 * 16 + hi * 8) * 2;
        const bf16x8 b0 = *reinterpret_cast<const bf16x8*>(Ks + koff<DKB>(r32, cb));
        const bf16x8 b1 = *reinterpret_cast<const bf16x8*>(Ks + koff<DKB>(32 + r32, cb));
        p0 = __builtin_amdgcn_mfma_f32_32x32x16_bf16(b0, qr[d0], p0, 0, 0, 0);
        p1 = __builtin_amdgcn_mfma_f32_32x32x16_bf16(b1, qr[d0], p1, 0, 0, 0); }
}
__device__ __forceinline__ int v_st(int k, int c) { const int kk = (k & ~0xC) | ((k & 4) << 1) | ((k & 8) >> 1); return ((kk >> 3) * 4 + (c >> 5)) * 512 + ((kk & 7) * 32 + (c & 31)) * 2; }
__device__ __forceinline__ int v_rd_base(int lane) { return ((lane & 3) << 3) | (((lane >> 2) & 3) << 6) | (((lane >> 4) & 1) << 5) | (((lane >> 5) & 1) << 8); }
constexpr int v_rd_off(int d0, int ks, int half) { return d0 * 512 + ks * 4096 + half * 2048; }
template <int OFF> __device__ __forceinline__ s16x4 tr_read(int vb) { s16x4 r; asm volatile("ds_read_b64_tr_b16 %0, %1 offset:%2" : "=&v"(r) : "v"(vb), "i"(OFF) : "memory"); return r; }
template <int D0> __device__ __forceinline__ void pv_one(f32x16& od, int vb, bf16x8 pa0, bf16x8 pa1, bf16x8 pa2, bf16x8 pa3) {
    const s16x4 l0 = tr_read<v_rd_off(D0, 0, 0)>(vb), h0 = tr_read<v_rd_off(D0, 0, 1)>(vb), l1 = tr_read<v_rd_off(D0, 1, 0)>(vb), h1 = tr_read<v_rd_off(D0, 1, 1)>(vb);
    const s16x4 l2 = tr_read<v_rd_off(D0, 2, 0)>(vb), h2 = tr_read<v_rd_off(D0, 2, 1)>(vb), l3 = tr_read<v_rd_off(D0, 3, 0)>(vb), h3 = tr_read<v_rd_off(D0, 3, 1)>(vb);
    asm volatile("s_waitcnt lgkmcnt(0)" ::: "memory"); AT_SBAR();
#define AT_PK(L, H) (bf16x8){L[0], L[1], L[2], L[3], H[0], H[1], H[2], H[3]}
    od = __builtin_amdgcn_mfma_f32_32x32x16_bf16(pa0, AT_PK(l0, h0), od, 0, 0, 0);
    od = __builtin_amdgcn_mfma_f32_32x32x16_bf16(pa1, AT_PK(l1, h1), od, 0, 0, 0);
    od = __builtin_amdgcn_mfma_f32_32x32x16_bf16(pa2, AT_PK(l2, h2), od, 0, 0, 0);
    od = __builtin_amdgcn_mfma_f32_32x32x16_bf16(pa3, AT_PK(l3, h3), od, 0, 0, 0);
#undef AT_PK
}
__device__ __forceinline__ void pv_d0(f32x16* o, int vb, bf16x8 pa0, bf16x8 pa1, bf16x8 pa2, bf16x8 pa3) {
    pv_one<0>(o[0], vb, pa0, pa1, pa2, pa3); pv_one<1>(o[1], vb, pa0, pa1, pa2, pa3); pv_one<2>(o[2], vb, pa0, pa1, pa2, pa3); pv_one<3>(o[3], vb, pa0, pa1, pa2, pa3);
}
struct KeySrc { const bf16_t* kn; const bf16_t* kr; const bf16_t* v; int ldk, ldv, ctx0, lat0, nctx; };
constexpr int LDS_ATT_V = 0, LDS_ATT_K = 32768, LDS_ATT_W = 32768 + 2 * 24576, LDS_ATT_END = LDS_ATT_W + 2048;
template <int ND0, class Hook>
__device__ __forceinline__ void attn_unit(const bf16_t* __restrict__ Qb, const int ldq, const KeySrc ks, const int NT, const Hook& hook, const float C, const float THRS,
                                          bf16_t* __restrict__ Ob, const int ldo, char* lds, const int tid_in) {
    constexpr int DKB = ND0 * 32, SHM_V = 16384, SHM_K = 64 * DKB;
    int tid = tid_in; asm volatile("" : "+v"(tid));
    const int wid = tid >> 6, lane = tid & 63, r32 = lane & 31, hi = lane >> 5;
    char* V_lds = lds + LDS_ATT_V; char* K_lds = lds + LDS_ATT_K;
    float* wsf = (float*)(lds + LDS_ATT_W) + wid * 64; float* li_l = wsf; float* al_l = wsf + 32;
    float m_reg = -1e30f, l_reg = 0; f32x16 o[4] = {}; bf16x8 qr[ND0];
    const bf16_t* Qw = Qb + (long)(wid * 32 + r32) * ldq + hi * 8;
#pragma unroll
    for (int d0 = 0; d0 < ND0; ++d0) qr[d0] = *reinterpret_cast<const bf16x8*>(Qw + d0 * 16);
    const int sr = tid >> 4, sc = (tid & 15) * 8, vst0 = v_st(sr, sc), vst1 = v_st(32 + sr, sc);
    const int rr_ = tid >> 3, rc_ = (tid & 7) * 8;
    const int vb0 = (int)(uintptr_t)V_lds + v_rd_base(lane);
    bf16x8 vs0, vs1, ks0, ks1, kr0;
#define AT_KROW(t) ((t) < ks.nctx ? ks.ctx0 + (t) * 64 : ks.lat0 + ((t) - ks.nctx) * 64)
#define AT_SLOAD(t) do { const long k0_ = AT_KROW(t); vs0 = *reinterpret_cast<const bf16x8*>(ks.v + (k0_ + sr) * ks.ldv + sc); vs1 = *reinterpret_cast<const bf16x8*>(ks.v + (k0_ + 32 + sr) * ks.ldv + sc); \
    ks0 = *reinterpret_cast<const bf16x8*>(ks.kn + (k0_ + sr) * ks.ldk + sc); ks1 = *reinterpret_cast<const bf16x8*>(ks.kn + (k0_ + 32 + sr) * ks.ldk + sc); \
    if (ND0 == 12) kr0 = *reinterpret_cast<const bf16x8*>(ks.kr + (k0_ + rr_) * 64 + rc_); } while (0)
#define AT_SWRITE(b) do { *(bf16x8*)(V_lds + (b) * SHM_V + vst0) = vs0; *(bf16x8*)(V_lds + (b) * SHM_V + vst1) = vs1; \
    *(bf16x8*)(K_lds + (b) * SHM_K + koff<DKB>(sr, sc * 2)) = ks0; *(bf16x8*)(K_lds + (b) * SHM_K + koff<DKB>(32 + sr, sc * 2)) = ks1; \
    if (ND0 == 12) *(bf16x8*)(K_lds + (b) * SHM_K + koff<DKB>(rr_, 256 + rc_ * 2)) = kr0; } while (0)
#define AT_RESC(a) do { if (__any((a) < 1.f)) { if (hi == 0) al_l[r32] = (a); asm volatile("s_waitcnt lgkmcnt(0)" ::: "memory"); \
    _Pragma("unroll") for (int d = 0; d < 4; ++d) _Pragma("unroll") for (int r = 0; r < 16; ++r) o[d][r] *= al_l[crow(r, hi)]; } } while (0)
    f32x16 p0, p1; float mn, al; bf16x8 pa0, pa1, pa2, pa3;
    AT_SLOAD(0); asm volatile("s_waitcnt vmcnt(0)" ::: "memory"); AT_SWRITE(0); __syncthreads();
    AT_SLOAD(1);
    for (int j = 0; j < NT; ++j) {
        const int bsel = j & 1;
        AT_SBAR(); qkt<ND0, DKB>(p0, p1, K_lds + bsel * SHM_K, qr, r32, hi); hook(p0, p1, j);
        partialSM(p0, p1, m_reg, mn, al, C, THRS);
        AT_RESC(al);
        finishSM(p0, p1, al, l_reg, pa0, pa1, pa2, pa3); AT_SBAR();
        if (j + 1 < NT) { asm volatile("s_waitcnt vmcnt(0)" ::: "memory"); if (bsel) { AT_SWRITE(0); } else { AT_SWRITE(1); } }
        if (j + 2 < NT) { AT_SLOAD(j + 2); }
        AT_SBAR();
        pv_d0(o, vb0 + bsel * SHM_V, pa0, pa1, pa2, pa3);
        __syncthreads();
    }
    if (hi == 0) li_l[r32] = l_reg; asm volatile("s_waitcnt lgkmcnt(0)" ::: "memory");
    float rli[16];
#pragma unroll
    for (int r = 0; r < 16; ++r) rli[r] = __builtin_amdgcn_rcpf(li_l[crow(r, hi)]);
    bf16_t* Ow = Ob + (long)(wid * 32) * ldo;
#pragma unroll
    for (int r = 0; r < 16; ++r) { const int orow = crow(r, hi);
#pragma unroll
        for (int d0 = 0; d0 < 4; ++d0) Ow[(long)orow * ldo + d0 * 32 + r32] = f2bf(o[d0][r] * rli[r]); }
#undef AT_KROW
#undef AT_SLOAD
#undef AT_SWRITE
#undef AT_RESC
}
struct NoHook { __device__ __forceinline__ void operator()(f32x16&, f32x16&, int) const {} };
struct NaHook {
    const float* tab; int lo, r, rs, cq, cs, hi4;
    __device__ __forceinline__ void operator()(f32x16& p0, f32x16& p1, int t) const {
        if (t < 4) return;
        const int kr = lo + (t - 4);
        if (kr < rs || kr >= rs + 8) {
#pragma unroll
            for (int i = 0; i < 16; ++i) { p0[i] = -1.0e30f; p1[i] = -1.0e30f; }
            return; }
        const float* trow = tab + (kr - r + 7) * 32 + (15 - cq);
#pragma unroll
        for (int i = 0; i < 16; ++i) { const int ck = (i & 3) + 8 * (i >> 2) + hi4;
            p0[i] = ((unsigned)(ck - cs) < 16u) ? p0[i] + trow[ck] : -1.0e30f;
            p1[i] = ((unsigned)(ck + 32 - cs) < 16u) ? p1[i] + trow[ck + 32] : -1.0e30f; }
    }
};
}

template <int DK1, int DK2, class CF, class BiasF>
__device__ __forceinline__ void naive_attn_row(const bf16_t* q, float scale, int nkeys, const CF& chunk, const BiasF& bias, bf16_t* out, float* qs, int lane) {
    for (int d = lane; d < DK1 + DK2; d += 64) qs[d] = bf2f(q[d]);
    __builtin_amdgcn_wave_barrier();
    asm volatile("s_waitcnt lgkmcnt(0)" ::: "memory");
    float m = -3.0e38f, l = 0.f, o0 = 0.f, o1 = 0.f;
    for (int kt = 0; kt < nkeys; kt += 64) {
        const bf16_t *kn, *kr, *v; int kns, krs, vs;
        chunk(kt, kn, kns, kr, krs, v, vs);
        const bf16_t* k1 = kn + (size_t)lane * kns;
        float s = 0.f;
#pragma unroll 4
        for (int d = 0; d < DK1; d += 8) { const u32x4 w = *(const u32x4*)(k1 + d);
            s += qs[d] * __uint_as_float(w.x << 16) + qs[d + 1] * __uint_as_float(w.x & 0xffff0000u) + qs[d + 2] * __uint_as_float(w.y << 16) + qs[d + 3] * __uint_as_float(w.y & 0xffff0000u)
               + qs[d + 4] * __uint_as_float(w.z << 16) + qs[d + 5] * __uint_as_float(w.z & 0xffff0000u) + qs[d + 6] * __uint_as_float(w.w << 16) + qs[d + 7] * __uint_as_float(w.w & 0xffff0000u); }
        if (DK2 > 0) { const bf16_t* k2 = kr + (size_t)lane * krs;
#pragma unroll 4
            for (int d = 0; d < DK2; d += 8) { const u32x4 w = *(const u32x4*)(k2 + d); const float* qq = qs + DK1 + d;
                s += qq[0] * __uint_as_float(w.x << 16) + qq[1] * __uint_as_float(w.x & 0xffff0000u) + qq[2] * __uint_as_float(w.y << 16) + qq[3] * __uint_as_float(w.y & 0xffff0000u)
                   + qq[4] * __uint_as_float(w.z << 16) + qq[5] * __uint_as_float(w.z & 0xffff0000u) + qq[6] * __uint_as_float(w.w << 16) + qq[7] * __uint_as_float(w.w & 0xffff0000u); } }
        s = s * scale + bias(kt + lane);
        const float mn = fmaxf(m, wave_max(s));
        const float pj = __expf(s - mn), alpha = __expf(m - mn);
        l = l * alpha + wave_sum(pj); o0 *= alpha; o1 *= alpha; m = mn;
        for (int j = 0; j < 64; ++j) { const float pv = __int_as_float(__builtin_amdgcn_readlane(__float_as_int(pj), j)); const bf16_t* vr = v + (size_t)j * vs; o0 = fmaf(pv, bf2f(vr[lane]), o0); o1 = fmaf(pv, bf2f(vr[lane + 64]), o1); }
    }
    const float rl = 1.0f / l;
    out[lane] = f2bf(o0 * rl); out[lane + 64] = f2bf(o1 * rl);
}

#define DEFPTRS const __attribute__((address_space(4))) Params* kp_ = (const __attribute__((address_space(4))) Params*)__builtin_amdgcn_kernarg_segment_ptr(); asm volatile("" : "+s"(kp_)); \
    const __attribute__((address_space(4))) Params& p = *kp_; unsigned char* ws = p.ws; unsigned* ctl = (unsigned*)ws; (void)ctl; \
    int wave = wave_s; asm volatile("" : "+s"(wave)); int lane; asm volatile("v_mbcnt_lo_u32_b32 %0, -1, 0\n\tv_mbcnt_hi_u32_b32 %0, -1, %0" : "=v"(lane)); const int tid = wave * 64 + lane, gw = blockIdx.x * 8 + wave, NGW = gridDim.x * 8; (void)lane; (void)gw; (void)NGW; \
    float* ldsf = (float*)lds_raw; (void)ldsf; \
    float* MOD = (float*)(ws + CB_MOD); \
    float* ROPE = (float*)(ws + O_ROPE); float* COSL = (float*)(ws + O_COSL); float* WF = (float*)(ws + O_WF); float* SSQ = (float*)(ws + O_SSQ); \
    int* RTE = (int*)(ws + O_RTE); int* LIST = (int*)(ws + O_LIST); float* LW = (float*)(ws + O_LW); \
    bf16_t* H = (bf16_t*)(ws + O_H); float* XB = (float*)(ws + O_XB); bf16_t* HB = (bf16_t*)(ws + O_HB); \
    bf16_t* ZQ = (bf16_t*)(ws + O_ZQ); bf16_t* ZKV = (bf16_t*)(ws + O_ZKV); bf16_t* KR = (bf16_t*)(ws + O_KR); bf16_t* ZF = (bf16_t*)(ws + O_ZF); \
    bf16_t* NAQ = (bf16_t*)(ws + O_NAQ); bf16_t* NAK = (bf16_t*)(ws + O_NAK); bf16_t* NAV = (bf16_t*)(ws + O_NAV); \
    bf16_t* QB = (bf16_t*)(ws + O_QB); bf16_t* KN = (bf16_t*)(ws + O_KN); bf16_t* VB = (bf16_t*)(ws + O_VB); \
    bf16_t* UVL = (bf16_t*)(ws + O_UVL); bf16_t* UVC = (bf16_t*)(ws + O_UVC); \
    bf16_t* OM = (bf16_t*)(ws + O_OM); float* OF = (float*)(ws + O_OF); bf16_t* ON = (bf16_t*)(ws + O_ON); bf16_t* Y = (bf16_t*)(ws + O_Y); bf16_t* YE = (bf16_t*)(ws + O_YE);
__global__ void __launch_bounds__(512, 2) fwd_kernel(Params p) {
    extern __shared__ __attribute__((aligned(16))) unsigned char lds_raw[];
    volatile LAS unsigned* misc = (volatile LAS unsigned*)((LAS unsigned char*)lds_raw + LDS_MISC);
    const int wave_s = __builtin_amdgcn_readfirstlane((int)(threadIdx.x >> 6));
    if (threadIdx.x < 64) misc[threadIdx.x] = 0u;
    __syncthreads();
    if (p.ph_hi - p.ph_lo > 1) (void)xcd_barrier_post((unsigned*)p.ws + CW_BAR, misc);

    int ph = 0;
#define PHASE_BEGIN if (ph >= p.ph_lo && ph < p.ph_hi) { DEFPTRS for (int rep_ = (int)((REPEAT_MASK >> ph) & 1u); rep_ >= 0; --rep_) {
#define LAYERPTRS const float* g_attn = p.in[I_GATTN] + l * DM; const float* g_ffn = p.in[I_GFFN] + l * DM; (void)g_attn; (void)g_ffn; \
    int* cnt = (int*)(ctl + CW_CNT) + l * 32 * 64; int* rte = RTE + (size_t)l * MT * 4; int* list = LIST + (size_t)l * 32 * MT; float* lw = LW + (size_t)l * 32 * MT; (void)cnt; (void)rte; (void)list; (void)lw;
#define PHASE_END   if (rep_ > 0 || ph + 1 < p.ph_hi) { int l2_; asm volatile("v_mbcnt_lo_u32_b32 %0, -1, 0\n\tv_mbcnt_hi_u32_b32 %0, -1, %0" : "=v"(l2_)); XcdBarrier b_; b_.bar = (unsigned*)p.ws + CW_BAR; b_.x = xb_xcc_id(); b_.st = (volatile LAS unsigned*)((LAS unsigned char*)lds_raw + LDS_MISC); if (ph == 0) xcd_barrier<true>(b_, wave_s * 64 + l2_); else xcd_barrier<false>(b_, wave_s * 64 + l2_); } } } ++ph;

    PHASE_BEGIN
    {
        float* sl = ldsf;
        for (int task = blockIdx.x; task < 2 * 16 * 24; task += gridDim.x) {
            const int l = task / (16 * 24), r = task % (16 * 24), ks = r / 24, nb = r % 24, k0 = ks * 128, n = nb * 512 + tid;
            __syncthreads();
            for (int i = tid; i < 5 * 128; i += 512) { const int rr = i / 128, kk = i % 128; const float cv = rr < 4 ? p.in[I_C][rr * DM + k0 + kk] : p.in[I_CCTX][k0 + kk]; sl[i] = silu(cv); }
            __syncthreads();
            float a0 = 0.f, a1 = 0.f, a2 = 0.f, a3 = 0.f, a4 = 0.f;
            const float* w = p.in[I_WADA] + ((size_t)l * DM + k0) * (6 * DM) + n;
            for (int kk = 0; kk < 128; ++kk) { const float wv = w[(size_t)kk * (6 * DM)]; a0 = fmaf(sl[kk], wv, a0); a1 = fmaf(sl[128 + kk], wv, a1); a2 = fmaf(sl[256 + kk], wv, a2); a3 = fmaf(sl[384 + kk], wv, a3); a4 = fmaf(sl[512 + kk], wv, a4); }
            if (ks == 0) { const float bv = p.in[I_BADA][l * 6 * DM + n]; a0 += bv; a1 += bv; a2 += bv; a3 += bv; a4 += bv; }
            float* mo = XB + (size_t)ks * (2 * 5 * 6 * DM) + (size_t)(l * 5) * (6 * DM) + n;
            mo[0] = a0; mo[6 * DM] = a1; mo[12 * DM] = a2; mo[18 * DM] = a3; mo[24 * DM] = a4;
        }
        const int gt = blockIdx.x * 512 + tid, NT_ = gridDim.x * 512;
        for (int i = gt; i < SEQ * 32; i += NT_) { const int s = i >> 5, j = i & 31; const float invf = powf(10000.0f, -(float)(2 * (j & 15)) / 32.0f);
            const float pos = (float)(j < 16 ? (s >> 6) : (s & 63)); const float ang = pos * invf; ROPE[2 * i] = cosf(ang); ROPE[2 * i + 1] = sinf(ang); }
        for (int i = gt; i < SEQ; i += NT_) COSL[i] = cospif((float)i * (2.0f / (float)SEQ));
        float* trig = ldsf + 1024;
        __syncthreads();
        if (tid < 128) trig[tid] = cospif((float)tid * (1.0f / 64.0f));
        __syncthreads();
        for (int i = gt; i < 2 * 1024 * 512; i += NT_) { const int l = i >> 19, r = i & ((1 << 19) - 1), k = r >> 10, j = r & 1023, g = k >> 7, c = k & 127, jj = j & 511;
            const float* wf = p.in[I_WFNET] + ((size_t)l * FW + g * 128) * FW + jj; float a = 0.f; const int sh_ = (j < 512) ? 0 : 96;
#pragma unroll 8
            for (int m = 0; m < 128; ++m) { const float tv = trig[(m * c + sh_) & 127]; a = fmaf(tv, wf[(size_t)m * FW], a); }
            WF[((size_t)l * 1024 + j) * 512 + k] = a; ((bf16_t*)(ws + O_WFA))[((size_t)l * 1024 + j) * 512 + k] = f2bf(a); }
        for (int i = gt; i < SEQ * 4096 / 8; i += NT_) { const int k = i >> 9, kk0 = (i & 511) * 8; unsigned w[4];
#pragma unroll
            for (int q = 0; q < 4; ++q) { float v[2];
#pragma unroll
                for (int e = 0; e < 2; ++e) { const int kk = kk0 + 2 * q + e, n = kk & (SEQ - 1); const float ang = (float)((k * n) & (SEQ - 1)) * (1.0f / 1024.0f); v[e] = kk < SEQ ? cospif(ang) : -sinpif(ang); }
                w[q] = pk2(v[0], v[1]); }
            *(u32x4*)((bf16_t*)(ws + O_DFTL) + (size_t)k * 4096 + kk0) = (u32x4){w[0], w[1], w[2], w[3]}; }
        for (int i = gt; i < CTXL * 512 / 8; i += NT_) { const int k = i >> 6, kk0 = (i & 63) * 8; unsigned w[4];
#pragma unroll
            for (int q = 0; q < 4; ++q) { float v[2];
#pragma unroll
                for (int e = 0; e < 2; ++e) { const int kk = kk0 + 2 * q + e, n = kk & (CTXL - 1); const float ang = (float)((k * n) & (CTXL - 1)) * (1.0f / 128.0f); v[e] = kk < CTXL ? cospif(ang) : -sinpif(ang); }
                w[q] = pk2(v[0], v[1]); }
            *(u32x4*)((bf16_t*)(ws + O_DFTC) + (size_t)k * 512 + kk0) = (u32x4){w[0], w[1], w[2], w[3]}; }
        for (int i = gt; i < 2 * 192 * 2048 / 8; i += NT_) { const int l = i / (192 * 256), r = i % (192 * 256); *(u32x4*)((bf16_t*)(ws + O_WIN) + ((size_t)l * 3072 + 2880) * 2048 + (size_t)r * 8) = (u32x4){0u, 0u, 0u, 0u}; }
        {
            LAS float* scr = (LAS float*)((LAS unsigned char*)lds_raw + 16384 + wave * 8704);
            constexpr int N_IN = 32 * 90, N_UQ = 8 * 48, N_UKV = 4 * 64, N_OUT = 32 * 64, N_G = 32 * 32 * 16, N_D = 32 * 8 * 64, N_L = N_IN + N_UQ + N_UKV + N_OUT + 2 * N_G + N_D;
            for (int it = gw; it < 2 * N_L; it += NGW) {
                const int l = it / N_L; int r = it % N_L;
                if (r < N_IN) { const int kb = r / 90, nb = r % 90; tconv_item(p.in[I_WIN] + (size_t)l * DM * INC, INC, kb * 64, nb * 32, (bf16_t*)(ws + O_WIN) + ((size_t)l * 3072 + nb * 32) * 2048, 2048, 2048, nullptr, scr, lane); continue; } r -= N_IN;
                if (r < N_UQ) { const int kb = r / 48, nb = r % 48; tconv_item(p.in[I_WUQ] + (size_t)l * QL * 1536, 1536, kb * 64, nb * 32, (bf16_t*)(ws + O_WUQ) + ((size_t)l * 1536 + nb * 32) * 512, 512, 512, p.in[I_GQ] + l * QL, scr, lane); continue; } r -= N_UQ;
                if (r < N_UKV) { const int kb = r / 64, nb = r % 64; tconv_item(p.in[I_WUKV] + (size_t)l * KVL * 2048, 2048, kb * 64, nb * 32, (bf16_t*)(ws + O_WUKV) + ((size_t)l * 2048 + nb * 32) * 256, 256, 256, p.in[I_GKV] + l * KVL, scr, lane); continue; } r -= N_UKV;
                if (r < N_OUT) { const int kb = r / 64, nb = r % 64; tconv_item(p.in[I_WOUT] + (size_t)l * DM * DM, DM, kb * 64, nb * 32, (bf16_t*)(ws + O_WOUT) + ((size_t)l * 2048 + nb * 32) * 2048, 2048, 2048, nullptr, scr, lane); continue; } r -= N_OUT;
                if (r < 2 * N_G) { const int up = r >= N_G ? 1 : 0; if (up) r -= N_G; const int e = r / 512, q = r % 512, kb = q / 16, nb = q % 16, f0 = nb * 32;
                    const float* src = (up ? p.in[I_WUP] : p.in[I_WGATE]) + ((size_t)l * NEXP + e) * DM * DE;
                    tconv_item(src, DE, kb * 64, f0, (bf16_t*)(ws + O_WGU) + (((size_t)l * NEXP + e) * 1024 + (f0 >> 7) * 256 + up * 128 + (f0 & 127)) * 2048, 2048, 2048, nullptr, scr, lane); continue; } r -= 2 * N_G;
                { const int e = r / 512, q = r % 512, kb = q / 64, nb = q % 64;
                    tconv_item(p.in[I_WDOWN] + ((size_t)l * NEXP + e) * DE * DM, DM, kb * 64, nb * 32, (bf16_t*)(ws + O_WD) + (((size_t)l * NEXP + e) * 2048 + nb * 32) * 512, 512, 512, nullptr, scr, lane); }
            }
        }
    }
    PHASE_END
    PHASE_BEGIN
    {
        for (int i = blockIdx.x * 512 + tid; i < 2 * 5 * 6 * DM; i += gridDim.x * 512) { float a = 0.f;
#pragma unroll
            for (int ks = 0; ks < 16; ++ks) a += XB[(size_t)ks * (2 * 5 * 6 * DM) + i];
            MOD[i] = a; }
    }
    PHASE_END

    for (int l = 0; l < NLAYER; ++l) {
        const bool ctx_out = (l < NLAYER - 1);

        PHASE_BEGIN
        {   LAYERPTRS
            int* pcnt = (int*)(ctl + CW_CNT) + (l - 1) * 32 * 64; const int* prte = RTE + (size_t)(l - 1) * MT * 4;
            for (int r = gw; r < MT; r += NGW) {
                const int b = row_batch(r);
                const float* src = (l == 0) ? (r < T ? p.in[I_X] + (size_t)r * DM : p.in[I_CTX] + (size_t)(r - T) * DM) : XB + (size_t)r * DM;
                f32x4 v[8]; float ss = 0.f;
#pragma unroll
                for (int j = 0; j < 8; ++j) v[j] = *(const f32x4*)(src + 4 * lane + 256 * j);
                if (l > 0) {
                    int c_ = lane < 32 ? pcnt[lane * 64] : 0; int padded = (c_ + 255) & ~255; int incl = padded;
                    incl = wave_incl_scan32(incl, lane);
                    const int base_l = incl - padded;
                    const int e1 = __builtin_amdgcn_readfirstlane(prte[r * 4 + 0]), p1 = prte[r * 4 + 1], e2 = __builtin_amdgcn_readfirstlane(prte[r * 4 + 2]), p2 = prte[r * 4 + 3];
                    const int s1 = __builtin_amdgcn_readlane(base_l, e1) + p1, s2 = __builtin_amdgcn_readlane(base_l, e2) + p2;
                    const float* gf = modp(MOD, l - 1, b, 5);
                    const bf16_t* y1 = YE + (size_t)s1 * DM; const bf16_t* y2 = YE + (size_t)s2 * DM;
#pragma unroll
                    for (int j = 0; j < 8; ++j) { const int c0 = 4 * lane + 256 * j; const u32x2 a = *(const u32x2*)(y1 + c0), bb = *(const u32x2*)(y2 + c0); const f32x4 g = *(const f32x4*)(gf + c0);
                        v[j].x += g.x * (__uint_as_float(a.x << 16) + __uint_as_float(bb.x << 16)); v[j].y += g.y * (__uint_as_float(a.x & 0xffff0000u) + __uint_as_float(bb.x & 0xffff0000u));
                        v[j].z += g.z * (__uint_as_float(a.y << 16) + __uint_as_float(bb.y << 16)); v[j].w += g.w * (__uint_as_float(a.y & 0xffff0000u) + __uint_as_float(bb.y & 0xffff0000u));
                        *(f32x4*)(XB + (size_t)r * DM + c0) = v[j]; }
                }
#pragma unroll
                for (int j = 0; j < 8; ++j) ss += v[j].x * v[j].x + v[j].y * v[j].y + v[j].z * v[j].z + v[j].w * v[j].w;
                const float rstd = rsqrtf(wave_sum(ss) * (1.0f / DM) + EPS);
                const float* sh = modp(MOD, l, b, 0); const float* sc = modp(MOD, l, b, 1);
#pragma unroll
                for (int j = 0; j < 8; ++j) { const int c0 = 4 * lane + 256 * j; const f32x4 g = *(const f32x4*)(g_attn + c0), s_ = *(const f32x4*)(sc + c0), h_ = *(const f32x4*)(sh + c0);
                    const f32x4 o = v[j] * rstd * g * (s_ + 1.0f) + h_; u32x2 w; w.x = pk2(o.x, o.y); w.y = pk2(o.z, o.w); *(u32x2*)(H + (size_t)r * DM + c0) = w; }
            }
        }
        PHASE_END

        PHASE_BEGIN
#if OPT_L2
        {
            g8::DenseSched S{(const char*)H, (const char*)(ws + O_WIN) + (size_t)l * 3072 * 2048 * 2, MT / 256, 12, (int)gridDim.x, (int)blockIdx.x, (size_t)256 * 4096, (size_t)256 * 4096};
            EpiL2 E{ZQ, ZKV, KR, ZF, NAQ, NAK, NAV, SSQ, ROPE};
            g8::gemm_phase((LAS unsigned char*)lds_raw, tid, DM, 4096, 4096, S, E);
        }
#else
        {   LAYERPTRS
            const float* w_in = p.in[I_WIN] + (size_t)l * DM * INC;
            auto af = [&](int row, int k) { return bf2f(H[(size_t)row * DM + k]); };
            auto bf = [&](int k, int col) { return w_in[(size_t)k * INC + col]; };
            auto ef = [&](int row, int c0, const float (&v)[8]) {
                bf16_t* dst; float o[8];
#pragma unroll
                for (int j = 0; j < 8; ++j) o[j] = v[j];
                if (c0 < C_ZKV) { dst = ZQ + (size_t)row * QL + c0; float s = 0.f;
#pragma unroll
                    for (int j = 0; j < 8; ++j) s += v[j] * v[j]; SSQ[row * 96 + (c0 >> 3)] = s; }
                else if (c0 < C_ZKR) { dst = ZKV + (size_t)row * KVL + (c0 - C_ZKV); float s = 0.f;
#pragma unroll
                    for (int j = 0; j < 8; ++j) s += v[j] * v[j]; SSQ[row * 96 + (c0 >> 3)] = s; }
                else if (c0 < C_ZF) { dst = KR + (size_t)row * KRD + (c0 - C_ZKR);
                    if (row < T) { const float* rp = ROPE + ((size_t)(row & (SEQ - 1)) * 32 + ((c0 - C_ZKR) >> 1)) * 2;
#pragma unroll
                        for (int j = 0; j < 4; ++j) { const float cs = rp[2 * j], sn = rp[2 * j + 1]; o[2 * j] = v[2 * j] * cs - v[2 * j + 1] * sn; o[2 * j + 1] = v[2 * j] * sn + v[2 * j + 1] * cs; } } }
                else if (c0 < C_NAQ) dst = ZF + (size_t)row * FW + (c0 - C_ZF);
                else if (c0 < C_NAK) dst = NAQ + (size_t)row * NAW + (c0 - C_NAQ);
                else if (c0 < C_NAV) dst = NAK + (size_t)row * NAW + (c0 - C_NAK);
                else dst = NAV + (size_t)row * NAW + (c0 - C_NAV);
                u32x4 w; w.x = pk2(o[0], o[1]); w.y = pk2(o[2], o[3]); w.z = pk2(o[4], o[5]); w.w = pk2(o[6], o[7]); *(u32x4*)dst = w;
            };
            sgemm_phase<false>(ldsf, MT, INC, DM, af, bf, ef);
        }
#endif
        PHASE_END

        PHASE_BEGIN
        {   LAYERPTRS
#if OPT_L3G
            {
                g8::DenseSched S{(const char*)ZQ, (const char*)(ws + O_WUQ) + (size_t)l * 1536 * 512 * 2, (ctx_out ? MT : T) / 256, 6, (int)gridDim.x, (int)((blockIdx.x + gridDim.x / 2) % gridDim.x), (size_t)256 * 1024, (size_t)256 * 1024};
                EpiQ E{QB, SSQ, ROPE};
                g8::gemm_phase((LAS unsigned char*)lds_raw, tid, QL, 1024, 1024, S, E);
            }
            {
                g8::DenseSched S{(const char*)ZKV, (const char*)(ws + O_WUKV) + (size_t)l * 2048 * 256 * 2, MT / 256, 8, (int)gridDim.x, (int)((blockIdx.x + gridDim.x / 2) % gridDim.x), (size_t)256 * 512, (size_t)256 * 512};
                EpiKV E{KN, VB, SSQ};
                g8::gemm_phase((LAS unsigned char*)lds_raw, tid, KVL, 512, 512, S, E);
            }
            {
                g8::DenseSched S{(const char*)(ws + O_WFA) + (size_t)l * 1024 * 512 * 2, (const char*)ZF, 4, (ctx_out ? MT : T) / 256, (int)gridDim.x, (int)((blockIdx.x + gridDim.x / 2) % gridDim.x), (size_t)256 * 1024, (size_t)256 * 1024};
                EpiF1 E{UVL, UVC};
                g8::gemm_phase((LAS unsigned char*)lds_raw, tid, 512, 1024, 1024, S, E);
            }
#else
            {
                const float* g_q = p.in[I_GQ] + l * QL; const float* w_uq = p.in[I_WUQ] + (size_t)l * QL * (NH * DQK);
                auto af = [&](int row, int k) { return bf2f(ZQ[(size_t)row * QL + k]) * g_q[k]; };
                auto bf = [&](int k, int col) { return w_uq[(size_t)k * (NH * DQK) + col]; };
                auto ef = [&](int row, int c0, const float (&v)[8]) {
                    const float rstd = rsqrtf(ssq_q(SSQ, row) * (1.0f / QL) + EPS); float o[8];
#pragma unroll
                    for (int j = 0; j < 8; ++j) o[j] = v[j] * rstd;
                    const int ch = c0 % DQK;
                    if (row < T && ch >= DNOPE) { const float* rp = ROPE + ((size_t)(row & (SEQ - 1)) * 32 + ((ch - DNOPE) >> 1)) * 2;
#pragma unroll
                        for (int j = 0; j < 4; ++j) { const float cs = rp[2 * j], sn = rp[2 * j + 1], x1 = o[2 * j], x2 = o[2 * j + 1]; o[2 * j] = x1 * cs - x2 * sn; o[2 * j + 1] = x1 * sn + x2 * cs; } }
                    u32x4 w; w.x = pk2(o[0], o[1]); w.y = pk2(o[2], o[3]); w.z = pk2(o[4], o[5]); w.w = pk2(o[6], o[7]); *(u32x4*)(QB + (size_t)row * (NH * DQK) + c0) = w;
                };
                sgemm_phase<false>(ldsf, ctx_out ? MT : T, NH * DQK, QL, af, bf, ef);
            }
            {
                const float* g_kv = p.in[I_GKV] + l * KVL; const float* w_ukv = p.in[I_WUKV] + (size_t)l * KVL * (NH * 256);
                auto af = [&](int row, int k) { return bf2f(ZKV[(size_t)row * KVL + k]) * g_kv[k]; };
                auto bf = [&](int k, int col) { return w_ukv[(size_t)k * (NH * 256) + col]; };
                auto ef = [&](int row, int c0, const float (&v)[8]) {
                    const float rstd = rsqrtf(ssq_kv(SSQ, row) * (1.0f / KVL) + EPS);
                    const int h = c0 >> 8, c = c0 & 255;
                    bf16_t* dst = (c < 128) ? KN + ((size_t)row * NH + h) * DNOPE + c : VB + ((size_t)row * NH + h) * DV + (c - 128);
                    u32x4 w; w.x = pk2(v[0] * rstd, v[1] * rstd); w.y = pk2(v[2] * rstd, v[3] * rstd); w.z = pk2(v[4] * rstd, v[5] * rstd); w.w = pk2(v[6] * rstd, v[7] * rstd); *(u32x4*)dst = w;
                };
                sgemm_phase<false>(ldsf, MT, NH * 256, KVL, af, bf, ef);
            }
            {
                const float* wf = WF + (size_t)l * 1024 * 512;
                auto af = [&](int row, int k) { return wf[(size_t)row * 512 + k]; };
                auto bf = [&](int k, int col) { return bf2f(ZF[(size_t)col * FW + k]); };
                auto ef = [&](int j, int n0, const float (&v)[8]) {
                    bf16_t* dst;
                    if (n0 < T) { const int b = n0 >> 11, s = n0 & (SEQ - 1); dst = UVL + ((size_t)b * 512 + (j & 511)) * 4096 + (j >> 9) * SEQ + s; }
                    else { const int n1 = n0 - T, b = n1 >> 8, s = n1 & 255; dst = UVC + ((size_t)b * 512 + (j & 511)) * 512 + (j >> 9) * CTXL + s; }
                    u32x4 w; w.x = pk2(v[0], v[1]); w.y = pk2(v[2], v[3]); w.z = pk2(v[4], v[5]); w.w = pk2(v[6], v[7]); *(u32x4*)dst = w;
                };
                sgemm_phase<true>(ldsf, 1024, ctx_out ? MT : T, 512, af, bf, ef);
            }
#endif
#if OPT_ATT
            {
                const float* rpb = p.in[I_RPB] + (size_t)l * NAH * 15 * 31;
                const float sc = 0.08838834764831845f;
                float* tab = (float*)(lds_raw + at::LDS_ATT_END);
                for (int unit = blockIdx.x; unit < NB * NAH * 8; unit += gridDim.x) {
                    const int b = unit >> 5, h = (unit >> 3) & 3, u4 = unit & 7;
                    __syncthreads();
                    if (tid < 480) { const int d = tid >> 5, c = tid & 31; tab[tid] = c < 31 ? rpb[(h * 15 + d) * 31 + c] * (1.0f / sc) : 0.f; }
                    __syncthreads();
                    const int lo = min(max(4 * u4 - 4, 0), 24), hi_ = min(max(4 * u4 - 1, 0), 24) + 8; int nr = hi_ - lo; nr += nr & 1;
                    const at::KeySrc ks{NAK + h * NAD, nullptr, NAV + h * NAD, NAW, NAW, T + b * CTXL, b * SEQ + lo * 64, 4};
                    const int r = 4 * u4 + (wave >> 1), cq = (wave & 1) * 32 + (lane & 31);
                    const at::NaHook hook{tab, lo, r, min(max(r - 4, 0), 24), cq, min(max(cq - 8, 0), 48), 4 * (lane >> 5)};
                    const size_t qo = (size_t)(b * SEQ + u4 * 256) * NAW + h * NAD;
                    at::attn_unit<8>(NAQ + qo, NAW, ks, 4 + nr, hook, sc * 1.4426950408889634f, 8.0f / sc, ON + qo, NAW, (char*)lds_raw, tid);
                }
            }
#else
            {
                const float* rpb = p.in[I_RPB] + (size_t)l * NAH * 15 * 31;
                float* qs = ldsf + wave * 256;
                const float sc = 0.08838834764831845f;
                for (int task = gw; task < T * NAH; task += NGW) {
                    const int row = task >> 2, h = task & 3, b = row >> 11, s = row & (SEQ - 1), r = s >> 6, cq = s & 63;
                    const int rs = min(max(r - 4, 0), 24), cs = min(max(cq - 8, 0), 48);
                    auto chunk = [&](int kt, const bf16_t*& kn, int& kns, const bf16_t*& kr, int& krs, const bf16_t*& v, int& vs) {
                        const int krow = (kt < CTXL) ? (T + b * CTXL + kt) : (b * SEQ + rs * 64 + (kt - CTXL));
                        kn = NAK + (size_t)krow * NAW + h * NAD; kns = NAW; kr = nullptr; krs = 0; v = NAV + (size_t)krow * NAW + h * NAD; vs = NAW; };
                    auto bias = [&](int key) { if (key < CTXL) return 0.f; const int jl = key - CTXL, kri = jl >> 6, ck = jl & 63;
                        if (ck < cs || ck >= cs + 16) return -1.0e30f; const int drow = rs + kri - r + 7, dcol = min(max(ck - cq + 15, 0), 30); return rpb[(h * 15 + drow) * 31 + dcol]; };
                    naive_attn_row<128, 0>(NAQ + (size_t)row * NAW + h * NAD, sc, CTXL + 512, chunk, bias, ON + (size_t)row * NAW + h * NAD, qs, lane);
                }
            }
#endif
        }
        PHASE_END

        PHASE_BEGIN
        {   LAYERPTRS
#if OPT_ATT
            {
                const float msc = 0.07216878364870323f, nsc = 0.08838834764831845f;
                for (int u = blockIdx.x; u < NB * NH * 8; u += gridDim.x) {
                    const int xcd = u & 7, idx = u >> 3, bh = xcd * 4 + (idx >> 3), qblk = idx & 7, b = bh >> 3, h = bh & 7;
                    const at::KeySrc ks{KN + h * DNOPE, KR, VB + h * DV, NH * DNOPE, NH * DV, T + b * CTXL, b * SEQ, 4};
                    const size_t r0 = (size_t)b * SEQ + qblk * 256;
                    at::attn_unit<12>(QB + (r0 * NH + h) * DQK, NH * DQK, ks, 4 + SEQ / 64, at::NoHook{}, msc * 1.4426950408889634f, 8.0f / msc, OM + r0 * 1024 + h * DV, 1024, (char*)lds_raw, tid);
                }
                if (ctx_out) {
                    for (int u = (int)gridDim.x - 1 - (int)blockIdx.x; u < NB * NH; u += gridDim.x) {
                        const int b = u >> 3, h = u & 7;
                        const at::KeySrc ks{KN + h * DNOPE, KR, VB + h * DV, NH * DNOPE, NH * DV, T + b * CTXL, 0, 4};
                        const size_t r0 = (size_t)T + b * CTXL;
                        at::attn_unit<12>(QB + (r0 * NH + h) * DQK, NH * DQK, ks, 4, at::NoHook{}, msc * 1.4426950408889634f, 8.0f / msc, OM + r0 * 1024 + h * DV, 1024, (char*)lds_raw, tid);
                    }
                    for (int u = (int)gridDim.x - 33 - (int)blockIdx.x; u >= 0 && u < NB * NAH; u += gridDim.x) {
                        const int b = u >> 2, h = u & 3;
                        const at::KeySrc ks{NAK + h * NAD, nullptr, NAV + h * NAD, NAW, NAW, T + b * CTXL, 0, 4};
                        const size_t qo = (size_t)(T + b * CTXL) * NAW + h * NAD;
                        at::attn_unit<8>(NAQ + qo, NAW, ks, 4, at::NoHook{}, nsc * 1.4426950408889634f, 8.0f / nsc, ON + qo, NAW, (char*)lds_raw, tid);
                    }
                }
            }
#else
            float* qs = ldsf + wave * 256;
            const float msc = 0.07216878364870323f;
            for (int task = gw; task < T * NH; task += NGW) {
                const int row = task >> 3, h = task & 7, b = row >> 11;
                auto chunk = [&](int kt, const bf16_t*& kn, int& kns, const bf16_t*& kr, int& krs, const bf16_t*& v, int& vs) {
                    const int krow = (kt < CTXL) ? (T + b * CTXL + kt) : (b * SEQ + (kt - CTXL));
                    kn = KN + ((size_t)krow * NH + h) * DNOPE; kns = NH * DNOPE; kr = KR + (size_t)krow * KRD; krs = KRD; v = VB + ((size_t)krow * NH + h) * DV; vs = NH * DV; };
                auto bias = [&](int) { return 0.f; };
                naive_attn_row<128, 64>(QB + ((size_t)row * NH + h) * DQK, msc, CTXL + SEQ, chunk, bias, OM + (size_t)row * 1024 + h * DV, qs, lane);
            }
            if (ctx_out) {
                for (int task = gw; task < TC * NH; task += NGW) {
                    const int row = T + (task >> 3), h = task & 7, b = (task >> 3) >> 8;
                    auto chunk = [&](int kt, const bf16_t*& kn, int& kns, const bf16_t*& kr, int& krs, const bf16_t*& v, int& vs) {
                        const int krow = T + b * CTXL + kt;
                        kn = KN + ((size_t)krow * NH + h) * DNOPE; kns = NH * DNOPE; kr = KR + (size_t)krow * KRD; krs = KRD; v = VB + ((size_t)krow * NH + h) * DV; vs = NH * DV; };
                    auto bias = [&](int) { return 0.f; };
                    naive_attn_row<128, 64>(QB + ((size_t)row * NH + h) * DQK, msc, CTXL, chunk, bias, OM + (size_t)row * 1024 + h * DV, qs, lane);
                }
                for (int task = gw; task < TC * NAH; task += NGW) {
                    const int row = T + (task >> 2), h = task & 3, b = (task >> 2) >> 8;
                    auto chunk = [&](int kt, const bf16_t*& kn, int& kns, const bf16_t*& kr, int& krs, const bf16_t*& v, int& vs) {
                        const int krow = T + b * CTXL + kt;
                        kn = NAK + (size_t)krow * NAW + h * NAD; kns = NAW; kr = nullptr; krs = 0; v = NAV + (size_t)krow * NAW + h * NAD; vs = NAW; };
                    auto bias = [&](int) { return 0.f; };
                    naive_attn_row<128, 0>(NAQ + (size_t)row * NAW + h * NAD, 0.08838834764831845f, CTXL, chunk, bias, ON + (size_t)row * NAW + h * NAD, qs, lane);
                }
            }
#endif
            __syncthreads();
            const float* bfn = p.in[I_BFNET] + l * FW;
#if OPT_F2
            {
                F2Sched S{(const char*)(ws + O_DFTL), (const char*)UVL, 8, 4, (int)gridDim.x, (int)blockIdx.x, (size_t)256 * 8192, (size_t)256 * 8192, (size_t)512 * 8192, (size_t)2048};
                EpiF2 E{OF, SEQ, 0};
                g8::gemm_phase((LAS unsigned char*)lds_raw, tid, SEQ / 2, 8192, 8192, S, E);
            }
            if (ctx_out) {
                F2Sched S{(const char*)(ws + O_DFTC), (const char*)UVC, 1, 1, (int)gridDim.x, (int)((blockIdx.x + 128) % gridDim.x), (size_t)256 * 1024, (size_t)256 * 1024, (size_t)512 * 1024, (size_t)0};
                EpiF2 E{OF, CTXL, T};
                g8::gemm_phase((LAS unsigned char*)lds_raw, tid, 2 * CTXL, 1024, 1024, S, E);
            }
#else
            for (int b = 0; b < NB; ++b) {
                auto af = [&](int k, int kk) { const int n = kk & (SEQ - 1); const int idx = (k * n) & (SEQ - 1); return kk < SEQ ? COSL[idx] : -COSL[(idx - SEQ / 4) & (SEQ - 1)]; };
                auto bf = [&](int kk, int j) { return bf2f(UVL[((size_t)b * 512 + j) * 4096 + kk]); };
                auto ef = [&](int k, int j0, const float (&v)[8]) { const float sc = 0.001953125f;
                    float* dst = OF + (size_t)(b * SEQ + k) * FW + j0;
#pragma unroll
                    for (int j = 0; j < 8; ++j) dst[j] = v[j] * sc + bfn[j0 + j]; };
                sgemm_phase<true>(ldsf, SEQ, FW, 2 * SEQ, af, bf, ef);
            }
            if (ctx_out) {
                for (int b = 0; b < NB; ++b) {
                    auto af = [&](int k, int kk) { const int n = kk & (CTXL - 1); const int idx = ((k * n) & (CTXL - 1)) * (SEQ / CTXL); return kk < CTXL ? COSL[idx] : -COSL[(idx - SEQ / 4) & (SEQ - 1)]; };
                    auto bf = [&](int kk, int j) { return bf2f(UVC[((size_t)b * 512 + j) * 512 + kk]); };
                    auto ef = [&](int k, int j0, const float (&v)[8]) { const float sc = 0.005524271728019903f;
                        float* dst = OF + (size_t)(T + b * CTXL + k) * FW + j0;
#pragma unroll
                        for (int j = 0; j < 8; ++j) dst[j] = v[j] * sc + bfn[j0 + j]; };
                    sgemm_phase<true>(ldsf, CTXL, FW, 2 * CTXL, af, bf, ef);
                }
            }
#endif
        }
        PHASE_END

        PHASE_BEGIN
        {   LAYERPTRS
            const float* g_out = p.in[I_GOUT] + l * DM; const float* bfn5 = p.in[I_BFNET] + l * FW; (void)bfn5;
            const int rows = ctx_out ? MT : T;
            for (int r = gw; r < rows; r += NGW) {
                float vm[16], vf[8], vn[8]; float s1 = 0.f, s2 = 0.f, s3 = 0.f;
#pragma unroll
                for (int j = 0; j < 4; ++j) { const u32x2 a = *(const u32x2*)(OM + (size_t)r * 1024 + 4 * lane + 256 * j); vm[4 * j] = __uint_as_float(a.x << 16); vm[4 * j + 1] = __uint_as_float(a.x & 0xffff0000u); vm[4 * j + 2] = __uint_as_float(a.y << 16); vm[4 * j + 3] = __uint_as_float(a.y & 0xffff0000u); }
#pragma unroll
#if OPT_F2
                for (int j = 0; j < 2; ++j) { const int c0 = 4 * lane + 256 * j; f32x4 a = *(const f32x4*)(OF + (size_t)r * FW + c0);
                    if (r < T) a = ((a + *(const f32x4*)(OF + ((size_t)MT + r) * FW + c0)) + *(const f32x4*)(OF + ((size_t)2 * MT + r) * FW + c0)) + *(const f32x4*)(OF + ((size_t)3 * MT + r) * FW + c0);
                    a = a * (r < T ? 0.001953125f : 0.005524271728019903f) + *(const f32x4*)(bfn5 + c0);
                    vf[4 * j] = a.x; vf[4 * j + 1] = a.y; vf[4 * j + 2] = a.z; vf[4 * j + 3] = a.w; }
#else
                for (int j = 0; j < 2; ++j) { const f32x4 a = *(const f32x4*)(OF + (size_t)r * FW + 4 * lane + 256 * j); vf[4 * j] = a.x; vf[4 * j + 1] = a.y; vf[4 * j + 2] = a.z; vf[4 * j + 3] = a.w; }
#endif
#pragma unroll
                for (int j = 0; j < 2; ++j) { const u32x2 a = *(const u32x2*)(ON + (size_t)r * NAW + 4 * lane + 256 * j); vn[4 * j] = __uint_as_float(a.x << 16); vn[4 * j + 1] = __uint_as_float(a.x & 0xffff0000u); vn[4 * j + 2] = __uint_as_float(a.y << 16); vn[4 * j + 3] = __uint_as_float(a.y & 0xffff0000u); }
#pragma unroll
                for (int j = 0; j < 16; ++j) s1 += vm[j] * vm[j];
#pragma unroll
                for (int j = 0; j < 8; ++j) { s2 += vf[j] * vf[j]; s3 += vn[j] * vn[j]; }
                const float r1 = rsqrtf(wave_sum(s1) * (1.0f / 1024.0f) + EPS), r2 = rsqrtf(wave_sum(s2) * (1.0f / 512.0f) + EPS), r3 = rsqrtf(wave_sum(s3) * (1.0f / 512.0f) + EPS);
                bf16_t* yr = Y + (size_t)r * DM;
#pragma unroll
                for (int j = 0; j < 4; ++j) { const int c0 = 4 * lane + 256 * j; const f32x4 g = *(const f32x4*)(g_out + c0); u32x2 w; w.x = pk2(vm[4 * j] * r1 * g.x, vm[4 * j + 1] * r1 * g.y); w.y = pk2(vm[4 * j + 2] * r1 * g.z, vm[4 * j + 3] * r1 * g.w); *(u32x2*)(yr + c0) = w; }
#pragma unroll
                for (int j = 0; j < 2; ++j) { const int c0 = 4 * lane + 256 * j; const f32x4 g = *(const f32x4*)(g_out + 1024 + c0); u32x2 w; w.x = pk2(vf[4 * j] * r2 * g.x, vf[4 * j + 1] * r2 * g.y); w.y = pk2(vf[4 * j + 2] * r2 * g.z, vf[4 * j + 3] * r2 * g.w); *(u32x2*)(yr + 1024 + c0) = w; }
#pragma unroll
                for (int j = 0; j < 2; ++j) { const int c0 = 4 * lane + 256 * j; const f32x4 g = *(const f32x4*)(g_out + 1536 + c0); u32x2 w; w.x = pk2(vn[4 * j] * r3 * g.x, vn[4 * j + 1] * r3 * g.y); w.y = pk2(vn[4 * j + 2] * r3 * g.z, vn[4 * j + 3] * r3 * g.w); *(u32x2*)(yr + 1536 + c0) = w; }
            }
        }
        PHASE_END

        PHASE_BEGIN
#if OPT_L6
        {
            g8::DenseSched S{(const char*)Y, (const char*)(ws + O_WOUT) + (size_t)l * 2048 * 2048 * 2, (ctx_out ? MT : T) / 256, 8, (int)gridDim.x, (int)blockIdx.x, (size_t)256 * 4096, (size_t)256 * 4096};
            EpiOut E{XB, p.in[I_X], p.in[I_CTX], MOD + (size_t)l * 5 * 6 * DM, l};
            g8::gemm_phase((LAS unsigned char*)lds_raw, tid, DM, 4096, 4096, S, E);
        }
#else
        {   LAYERPTRS
            const float* w_out = p.in[I_WOUT] + (size_t)l * DM * DM; const float* x_in = p.in[I_X]; const float* ctx_in = p.in[I_CTX];
            auto af = [&](int row, int k) { return bf2f(Y[(size_t)row * DM + k]); };
            auto bf = [&](int k, int col) { return w_out[(size_t)k * DM + col]; };
            auto ef = [&](int row, int c0, const float (&v)[8]) {
                const int b = row_batch(row); const float* ga = modp(MOD, l, b, 2) + c0;
                const float* xr = (l == 0) ? (row < T ? x_in + (size_t)row * DM : ctx_in + (size_t)(row - T) * DM) : XB + (size_t)row * DM;
                float* dst = XB + (size_t)row * DM + c0;
#pragma unroll
                for (int j = 0; j < 8; ++j) dst[j] = xr[c0 + j] + ga[j] * v[j];
            };
            sgemm_phase<false>(ldsf, ctx_out ? MT : T, DM, DM, af, bf, ef);
        }
#endif
        PHASE_END

        PHASE_BEGIN
        {   LAYERPTRS
            const float* w_rg = p.in[I_WRG] + (size_t)l * DM * NGRP; const float* b_rg = p.in[I_BRG] + l * NGRP;
            const float* w_re = p.in[I_WRE] + (size_t)l * DM * NEXP; const float* b_re = p.in[I_BRE] + l * NEXP;
            const int rows = ctx_out ? MT : T;
            float wreg[8][4][4], wgr[4][4];
#pragma unroll
            for (int j = 0; j < 8; ++j)
#pragma unroll
                for (int t = 0; t < 4; ++t) { const int k = 4 * lane + 256 * j + t;
#pragma unroll
                    for (int q = 0; q < 4; ++q) wreg[j][t][q] = w_re[(size_t)k * NEXP + 4 * wave + q]; }
#pragma unroll
            for (int j = 0; j < 4; ++j)
#pragma unroll
                for (int t = 0; t < 4; ++t) { const int k = 4 * lane + 256 * (j + 4 * (wave >> 2)) + t; wgr[j][t] = w_rg[(size_t)k * NGRP + (wave & 3)]; }
            float* hfs = ldsf;
            float* lgs = ldsf + 8 * DM;
            for (int g = blockIdx.x; g < rows / 8; g += gridDim.x) {
                const int r = g * 8 + wave; const int b = row_batch(r);
                {
                    f32x4 v[8]; float ss = 0.f;
#pragma unroll
                    for (int j = 0; j < 8; ++j) { v[j] = *(const f32x4*)(XB + (size_t)r * DM + 4 * lane + 256 * j); ss += v[j].x * v[j].x + v[j].y * v[j].y + v[j].z * v[j].z + v[j].w * v[j].w; }
                    const float rstd = rsqrtf(wave_sum(ss) * (1.0f / DM) + EPS);
                    const float* sh = modp(MOD, l, b, 3); const float* sc = modp(MOD, l, b, 4);
#pragma unroll
                    for (int j = 0; j < 8; ++j) { const int c0 = 4 * lane + 256 * j; const f32x4 g_ = *(const f32x4*)(g_ffn + c0), s_ = *(const f32x4*)(sc + c0), h_ = *(const f32x4*)(sh + c0);
                        const f32x4 o = v[j] * rstd * g_ * (s_ + 1.0f) + h_; u32x2 w; w.x = pk2(o.x, o.y); w.y = pk2(o.z, o.w); *(u32x2*)(H + (size_t)r * DM + c0) = w;
                        *(f32x4*)(hfs + wave * DM + c0) = o; }
                }
                __syncthreads();
#pragma unroll 1
                for (int r4 = 0; r4 < 8; r4 += 4) {
                    float a[4][5];
#pragma unroll
                    for (int rr = 0; rr < 4; ++rr) {
#pragma unroll
                        for (int q = 0; q < 5; ++q) a[rr][q] = 0.f;
#pragma unroll
                        for (int j = 0; j < 8; ++j) { const f32x4 hv = *(const f32x4*)(hfs + (r4 + rr) * DM + 4 * lane + 256 * j);
#pragma unroll
                            for (int q = 0; q < 4; ++q) a[rr][q] = fmaf(hv.x, wreg[j][0][q], fmaf(hv.y, wreg[j][1][q], fmaf(hv.z, wreg[j][2][q], fmaf(hv.w, wreg[j][3][q], a[rr][q]))));
                            if ((j >> 2) == (wave >> 2)) a[rr][4] = fmaf(hv.x, wgr[j & 3][0], fmaf(hv.y, wgr[j & 3][1], fmaf(hv.z, wgr[j & 3][2], fmaf(hv.w, wgr[j & 3][3], a[rr][4])))); }
                    }
#pragma unroll
                    for (int o = 1; o < 64; o <<= 1) { float t_[4][5];
#pragma unroll
                        for (int rr = 0; rr < 4; ++rr)
#pragma unroll
                            for (int q = 0; q < 5; ++q) t_[rr][q] = shx(a[rr][q], o, lane);
#pragma unroll
                        for (int rr = 0; rr < 4; ++rr)
#pragma unroll
                            for (int q = 0; q < 5; ++q) a[rr][q] += t_[rr][q]; }
                    if (lane == 0) {
#pragma unroll
                        for (int rr = 0; rr < 4; ++rr) {
#pragma unroll
                            for (int q = 0; q < 4; ++q) lgs[(r4 + rr) * 48 + 8 + 4 * wave + q] = a[rr][q];
                            lgs[(r4 + rr) * 48 + wave] = a[rr][4]; } }
                }
                __syncthreads();
                float lg[4], le[32];
#pragma unroll
                for (int j = 0; j < 4; ++j) lg[j] = (lgs[wave * 48 + j] + lgs[wave * 48 + 4 + j]) + b_rg[j];
#pragma unroll
                for (int j = 0; j < 32; ++j) le[j] = lgs[wave * 48 + 8 + j] + b_re[j];
                int gsel = 0; float mg = lg[0];
#pragma unroll
                for (int j = 1; j < 4; ++j) if (lg[j] > mg) { mg = lg[j]; gsel = j; }
                float sg = 0.f;
#pragma unroll
                for (int j = 0; j < 4; ++j) sg += __expf(lg[j] - mg);
                const float g_w = 1.0f / sg;
                float l8[8];
#pragma unroll
                for (int i = 0; i < 8; ++i) l8[i] = gsel == 0 ? le[i] : gsel == 1 ? le[8 + i] : gsel == 2 ? le[16 + i] : le[24 + i];
                int i1 = 0; float m1 = l8[0];
#pragma unroll
                for (int i = 1; i < 8; ++i) if (l8[i] > m1) { m1 = l8[i]; i1 = i; }
                int i2 = -1; float m2 = -3.0e38f;
#pragma unroll
                for (int i = 0; i < 8; ++i) if (i != i1 && l8[i] > m2) { m2 = l8[i]; i2 = i; }
                const float p2 = __expf(m2 - m1);
                const float w1 = g_w / (1.0f + p2), w2 = g_w * p2 / (1.0f + p2);
                if (lane == 0) {
                    const int e1 = gsel * 8 + i1, e2 = gsel * 8 + i2;
                    const int q1 = atomicAdd(&cnt[e1 * 64], 1), q2 = atomicAdd(&cnt[e2 * 64], 1);
                    list[(size_t)e1 * MT + q1] = r; lw[(size_t)e1 * MT + q1] = w1; list[(size_t)e2 * MT + q2] = r; lw[(size_t)e2 * MT + q2] = w2;
                    rte[r * 4 + 0] = e1; rte[r * 4 + 1] = q1; rte[r * 4 + 2] = e2; rte[r * 4 + 3] = q2;
                }
            }
        }
        PHASE_END

        PHASE_BEGIN
#if OPT_MOE
        {   LAYERPTRS
            LAS int* tp = (LAS int*)((LAS unsigned char*)lds_raw + LDS_TAB); LAS int* cn = tp + 33;
            __syncthreads();
            if (tid < 64) { const int c_ = tid < 32 ? cnt[(tid & 31) * 64] : 0; const int nt_ = (c_ + 255) >> 8; const int incl = wave_incl_scan32(nt_, tid); const int excl = incl - nt_;
                if (tid < 32) { cn[tid] = c_; tp[tid] = excl;
#pragma unroll 1
                    for (int q = 0; q < nt_; ++q) tp[80 + excl + q] = tid;
                    if (tid == 31) tp[32] = incl; } }
            __syncthreads();
            MoeSched1 S{(const char*)H, (const char*)(ws + O_WGU) + (size_t)l * NEXP * 1024 * 4096, list, tp, cn, (int)gridDim.x, (int)blockIdx.x};
            EpiGU E{HB, lw};
            g8::gemm_phase((LAS unsigned char*)lds_raw, tid, DM, 4096, 4096, S, E);
        }
#else
        {   LAYERPTRS
            int* s_base = (int*)(lds_raw + 65536);
            __syncthreads();
            if (tid == 0) { int a = 0; for (int e = 0; e < 32; ++e) { s_base[e] = a; a += (cnt[e * 64] + 255) & ~255; } s_base[32] = a; }
            __syncthreads();
            const float* w_gate = p.in[I_WGATE] + (size_t)l * NEXP * DM * DE; const float* w_up = p.in[I_WUP] + (size_t)l * NEXP * DM * DE;
            int tbase = 0;
            for (int e = 0; e < 32; ++e) {
                const int ce = cnt[e * 64], tm = (ce + 127) / 128, nt = tm * 8;
                const int* le_ = list + (size_t)e * MT; const float* lwe = lw + (size_t)e * MT; const int sb = s_base[e];
                const float* wg = w_gate + (size_t)e * DM * DE; const float* wu = w_up + (size_t)e * DM * DE;
                auto af = [&](int i, int k) { return bf2f(H[(size_t)le_[i] * DM + k]); };
                auto bf = [&](int k, int col) { return (col & 1) ? wu[(size_t)k * DE + (col >> 1)] : wg[(size_t)k * DE + (col >> 1)]; };
                auto ef = [&](int i, int c0, const float (&v)[8]) { const float w = lwe[i];
                    u32x2 o; o.x = pk2(silu(v[0]) * v[1] * w, silu(v[2]) * v[3] * w); o.y = pk2(silu(v[4]) * v[5] * w, silu(v[6]) * v[7] * w); *(u32x2*)(HB + (size_t)(sb + i) * DE + (c0 >> 1)) = o; };
                int first = ((int)blockIdx.x - tbase) % (int)gridDim.x; if (first < 0) first += gridDim.x;
                for (int t = first; t < nt; t += gridDim.x) sgemm_tile<false>(ldsf, (t >> 3) * 128, (t & 7) * 128, ce, 1024, DM, af, bf, ef);
                tbase += nt;
            }
        }
#endif
        PHASE_END

        PHASE_BEGIN
#if OPT_MOE
        {   LAYERPTRS
            LAS int* tp = (LAS int*)((LAS unsigned char*)lds_raw + LDS_TAB); LAS int* cn = tp + 33;
            __syncthreads();
            if (tid < 64) { const int c_ = tid < 32 ? cnt[(tid & 31) * 64] : 0; const int nt_ = (c_ + 255) >> 8; const int incl = wave_incl_scan32(nt_, tid); const int excl = incl - nt_;
                if (tid < 32) { cn[tid] = c_; tp[tid] = excl;
#pragma unroll 1
                    for (int q = 0; q < nt_; ++q) tp[80 + excl + q] = tid;
                    if (tid == 31) tp[32] = incl; } }
            __syncthreads();
            MoeSched2 S{(const char*)HB, (const char*)(ws + O_WD) + (size_t)l * NEXP * 2048 * 1024, tp, cn, (int)gridDim.x, (int)blockIdx.x};
            EpiDN E{YE};
            g8::gemm_phase((LAS unsigned char*)lds_raw, tid, DE, 1024, 1024, S, E);
        }
#else
        {   LAYERPTRS
            int* s_base2 = (int*)(lds_raw + 65536);
            __syncthreads();
            if (tid == 0) { int a = 0; for (int e = 0; e < 32; ++e) { s_base2[e] = a; a += (cnt[e * 64] + 255) & ~255; } s_base2[32] = a; }
            __syncthreads();
            const float* w_down = p.in[I_WDOWN] + (size_t)l * NEXP * DE * DM;
            int tbase = 0;
            for (int e = 0; e < 32; ++e) {
                const int ce = cnt[e * 64], tm = (ce + 127) / 128, nt = tm * 16; const int sb = s_base2[e];
                const float* wd = w_down + (size_t)e * DE * DM;
                auto af = [&](int i, int k) { return bf2f(HB[(size_t)(sb + i) * DE + k]); };
                auto bf = [&](int k, int col) { return wd[(size_t)k * DM + col]; };
                auto ef = [&](int i, int c0, const float (&v)[8]) { u32x4 w; w.x = pk2(v[0], v[1]); w.y = pk2(v[2], v[3]); w.z = pk2(v[4], v[5]); w.w = pk2(v[6], v[7]); *(u32x4*)(YE + (size_t)(sb + i) * DM + c0) = w; };
                int first = ((int)blockIdx.x - tbase) % (int)gridDim.x; if (first < 0) first += gridDim.x;
                for (int t = first; t < nt; t += gridDim.x) sgemm_tile<false>(ldsf, (t >> 4) * 128, (t & 15) * 128, ce, DM, DE, af, bf, ef);
                tbase += nt;
            }
        }
#endif
        PHASE_END
    }

    PHASE_BEGIN
    {
        const int l = NLAYER - 1;
        int* pcnt = (int*)(ctl + CW_CNT) + l * 32 * 64; const int* prte = RTE + (size_t)l * MT * 4;
        const float* gfin = p.in[I_GFINAL];
        for (int r = gw; r < T; r += NGW) {
            const int b = row_batch(r);
            f32x4 v[8]; float ss = 0.f;
#pragma unroll
            for (int j = 0; j < 8; ++j) v[j] = *(const f32x4*)(XB + (size_t)r * DM + 4 * lane + 256 * j);
            int c_ = lane < 32 ? pcnt[lane * 64] : 0; int padded = (c_ + 255) & ~255; int incl = padded;
            incl = wave_incl_scan32(incl, lane);
            const int base_l = incl - padded;
            const int e1 = __builtin_amdgcn_readfirstlane(prte[r * 4 + 0]), p1 = prte[r * 4 + 1], e2 = __builtin_amdgcn_readfirstlane(prte[r * 4 + 2]), p2 = prte[r * 4 + 3];
            const int s1 = __builtin_amdgcn_readlane(base_l, e1) + p1, s2 = __builtin_amdgcn_readlane(base_l, e2) + p2;
            const float* gf = modp(MOD, l, b, 5);
            const bf16_t* y1 = YE + (size_t)s1 * DM; const bf16_t* y2 = YE + (size_t)s2 * DM;
#pragma unroll
            for (int j = 0; j < 8; ++j) { const int c0 = 4 * lane + 256 * j; const u32x2 a = *(const u32x2*)(y1 + c0), bb = *(const u32x2*)(y2 + c0); const f32x4 g = *(const f32x4*)(gf + c0);
                v[j].x += g.x * (__uint_as_float(a.x << 16) + __uint_as_float(bb.x << 16)); v[j].y += g.y * (__uint_as_float(a.x & 0xffff0000u) + __uint_as_float(bb.x & 0xffff0000u));
                v[j].z += g.z * (__uint_as_float(a.y << 16) + __uint_as_float(bb.y << 16)); v[j].w += g.w * (__uint_as_float(a.y & 0xffff0000u) + __uint_as_float(bb.y & 0xffff0000u));
                ss += v[j].x * v[j].x + v[j].y * v[j].y + v[j].z * v[j].z + v[j].w * v[j].w; }
            const float rstd = rsqrtf(wave_sum(ss) * (1.0f / DM) + EPS);
#pragma unroll
            for (int j = 0; j < 8; ++j) { const int c0 = 4 * lane + 256 * j; const f32x4 g = *(const f32x4*)(gfin + c0); *(f32x4*)(p.out + (size_t)r * DM + c0) = v[j] * rstd * g; }
        }
    }
    PHASE_END
#undef PHASE_BEGIN
#undef PHASE_END
}

constexpr int NPHASES = 2 + 9 * NLAYER + 1;

extern "C" void kernel_launch(void* const* d_in, const int* in_sizes, int n_in, void* d_out, int out_size, void* d_ws, size_t ws_size, hipStream_t stream) {
    static int grid = 0;
    if (grid == 0) {
        if (n_in != 26 || out_size != T * DM || ws_size < WS_END) { fprintf(stderr, "kernel_launch: unexpected shapes (n_in %d out %d ws %zu need %zu)\n", n_in, out_size, ws_size, (size_t)WS_END); grid = -1; return; }
        int dev = 0, cus = 0, per_cu = 0;
        if (hipGetDevice(&dev) != hipSuccess || hipDeviceGetAttribute(&cus, hipDeviceAttributeMultiprocessorCount, dev) != hipSuccess) { grid = -1; return; }
        if (hipFuncSetAttribute((const void*)fwd_kernel, hipFuncAttributeMaxDynamicSharedMemorySize, LDS_BYTES) != hipSuccess) { fprintf(stderr, "kernel_launch: hipFuncSetAttribute failed\n"); grid = -1; return; }
        if (hipOccupancyMaxActiveBlocksPerMultiprocessor(&per_cu, (const void*)fwd_kernel, 512, LDS_BYTES) != hipSuccess || per_cu < 1) { fprintf(stderr, "kernel_launch: occupancy query says %d\n", per_cu); }
        (void)hipGetLastError();
        grid = cus;
    }
    if (grid < 0) return;
    (void)hipMemsetAsync(d_ws, 0, CTL_BYTES, stream);
    Params p{};
    for (int i = 0; i < 26; ++i) p.in[i] = (const float*)d_in[i];
    p.out = (float*)d_out; p.ws = (unsigned char*)d_ws;
#if ONE_LAUNCH
    p.ph_lo = 0; p.ph_hi = NPHASES;
    hipLaunchKernelGGL(fwd_kernel, dim3(grid), dim3(512), LDS_BYTES, stream, p);
#else
    for (int ph = 0; ph < NPHASES; ++ph) { p.ph_lo = ph; p.ph_hi = ph + 1; hipLaunchKernelGGL(fwd_kernel, dim3(grid), dim3(512), LDS_BYTES, stream, p); }
#endif
}
```
